# Optimizing an MI355X kernel written in HIP

```python
import math
import jax, jax.numpy as jnp
from jax import lax
import numpy as np

D_MODEL = 2048
BATCH = 2
SEQ = 8192
DEPTH = 1

CTX_LEN = 256
GRID_W = 64
MIX_WIDTH = D_MODEL
POOL_WIDTH = MIX_WIDTH // 2
SSM_WIDTH = MIX_WIDTH - POOL_WIDTH
POOL_WINDOWS = (2, 4, 8, 16)
POOL_GROUPS = len(POOL_WINDOWS)
POOL_GROUP_W = POOL_WIDTH // POOL_GROUPS
SSM_GROUP_CH = 16
SSM_GROUPS = SSM_WIDTH // SSM_GROUP_CH
SSM_STATE = 64
DT_MIN = 1e-3
DT_MAX = 1e-1
EPS = 1e-6

kernel_name = "hybrid_pool_s5_prefix_dit_block"


def _rmsnorm(v, g):
    v32 = v.astype(jnp.float32)
    out = v32 * lax.rsqrt(jnp.mean(v32 * v32, axis=-1, keepdims=True) + EPS)
    return (out * g.astype(jnp.float32)).astype(v.dtype)


def _centred_window_mean(v, window, axis):
    n = v.shape[axis]
    pad = [(0, 0)] * v.ndim
    pad[axis] = (1, 0)
    cs = jnp.pad(jnp.cumsum(v.astype(jnp.float32), axis=axis), pad)
    t = jnp.arange(n)
    lo = jnp.clip(t - window // 2, 0, n)
    hi = jnp.clip(t + window - window // 2, 0, n)
    s = jnp.take(cs, hi, axis=axis) - jnp.take(cs, lo, axis=axis)
    shape = [1] * v.ndim
    shape[axis] = n
    cnt = (hi - lo).astype(jnp.float32).reshape(shape)
    return (s / cnt).astype(v.dtype)


def _pool_mix(u, pool_w, pool_scale, axes):
    outs = []
    for g, w in enumerate(POOL_WINDOWS):
        ug = u[..., g * POOL_GROUP_W:(g + 1) * POOL_GROUP_W]
        m = ug
        for ax in axes:
            m = _centred_window_mean(m, w, ax)
        outs.append(jnp.einsum('...c,cd->...d', m - ug, pool_w[g]))
    return jnp.concatenate(outs, axis=-1) * pool_scale


def _linear_combine(left, right):
    a_l, b_l = left
    a_r, b_r = right
    return a_l * a_r, a_r * b_l + b_r


def _s5_scan(u, lam_re, lam_im, log_dt, b_re, b_im, h0, reverse):
    bsz, n = u.shape[0], u.shape[1]
    lam = lax.complex(lam_re.astype(jnp.float32), lam_im.astype(jnp.float32))
    dt = jnp.exp(log_dt.astype(jnp.float32))[:, None]
    a_bar = jnp.exp(lam * dt)
    b = lax.complex(b_re.astype(jnp.float32), b_im.astype(jnp.float32))
    b_bar = ((a_bar - 1.0) / lam)[..., None] * b
    ug = u.astype(jnp.float32).reshape(bsz, n, SSM_GROUPS, SSM_GROUP_CH)
    bu = lax.complex(jnp.einsum('blgh,gnh->blgn', ug, b_bar.real),
                     jnp.einsum('blgh,gnh->blgn', ug, b_bar.imag))
    first = n - 1 if reverse else 0
    bu = bu.at[:, first].add(a_bar * h0)
    a = jnp.broadcast_to(a_bar, bu.shape)
    _, hs = lax.associative_scan(_linear_combine, (a, bu), reverse=reverse, axis=1)
    return hs


def _s5_readout(hs, c_re, c_im):
    y = (jnp.einsum('blgn,ghn->blgh', hs.real, c_re.astype(jnp.float32))
         - jnp.einsum('blgn,ghn->blgh', hs.imag, c_im.astype(jnp.float32)))
    return y.reshape(hs.shape[0], hs.shape[1], SSM_WIDTH)


def _merge_branches(pool_out, u_ssm, hs_f, hs_b, z, c_re, c_im, d_skip, glu_w, glu_b, out_w):
    y = (_s5_readout(hs_f, c_re[0], c_im[0]) + _s5_readout(hs_b, c_re[1], c_im[1])).astype(u_ssm.dtype)
    y = jax.nn.gelu(y + d_skip * u_ssm)
    y1, y2 = jnp.split(y @ glu_w + glu_b, 2, axis=-1)
    ssm_out = y1 * jax.nn.sigmoid(y2)
    branch = jnp.concatenate([pool_out, ssm_out], axis=-1) * jax.nn.silu(z)
    return branch @ out_w


def _layer(x, ctx, c, c_ctx, ada_w, ada_b, norm_g, in_w, pool_w, pool_scale,
           lam_re, lam_im, log_dt, b_re, b_im, c_re, c_im, d_skip, glu_w, glu_b, out_w, update_ctx):
    bsz, seq = x.shape[0], x.shape[1]
    rows = seq // GRID_W
    shift, scale, gate = jnp.split(jax.nn.silu(c) @ ada_w + ada_b, 3, axis=-1)
    shift_c, scale_c, gate_c = jnp.split(jax.nn.silu(c_ctx) @ ada_w + ada_b, 3, axis=-1)
    h = _rmsnorm(x, norm_g) * (1.0 + scale[:, None]) + shift[:, None]
    hc = _rmsnorm(ctx, norm_g) * (1.0 + scale_c) + shift_c

    uc_ssm = hc @ in_w[:, POOL_WIDTH:MIX_WIDTH]
    zeros_h = jnp.zeros((bsz, SSM_GROUPS, SSM_STATE), jnp.complex64)
    hs_cf = _s5_scan(uc_ssm, lam_re[0], lam_im[0], log_dt[0], b_re[0], b_im[0], zeros_h, False)
    hs_cb = _s5_scan(uc_ssm, lam_re[1], lam_im[1], log_dt[1], b_re[1], b_im[1], zeros_h, True)
    if update_ctx:
        uc_pool = hc @ in_w[:, :POOL_WIDTH]
        zc = hc @ in_w[:, MIX_WIDTH:]
        pool_c = _pool_mix(uc_pool, pool_w, pool_scale, (1,))
        mix_c = _merge_branches(pool_c, uc_ssm, hs_cf, hs_cb, zc, c_re, c_im, d_skip, glu_w, glu_b, out_w)
        ctx = ctx + gate_c * mix_c

    proj = h @ in_w
    u_pool = proj[..., :POOL_WIDTH]
    u_ssm = proj[..., POOL_WIDTH:MIX_WIDTH]
    z = proj[..., MIX_WIDTH:]
    grid = u_pool.reshape(bsz, rows, GRID_W, POOL_WIDTH)
    pool_out = _pool_mix(grid, pool_w, pool_scale, (1, 2)).reshape(bsz, seq, POOL_WIDTH)
    hs_f = _s5_scan(u_ssm, lam_re[0], lam_im[0], log_dt[0], b_re[0], b_im[0], hs_cf[:, -1], False)
    hs_b = _s5_scan(u_ssm, lam_re[1], lam_im[1], log_dt[1], b_re[1], b_im[1], hs_cb[:, 0], True)
    mix = _merge_branches(pool_out, u_ssm, hs_f, hs_b, z, c_re, c_im, d_skip, glu_w, glu_b, out_w)
    x = x + gate[:, None] * mix
    return x, ctx


def setup_inputs(seed: int = 0) -> dict:
    key = jax.random.key(seed)
    k = jax.random.split(key, 24)
    nrm = jax.random.normal
    D, G, N, H = D_MODEL, SSM_GROUPS, SSM_STATE, SSM_GROUP_CH
    n_idx = jnp.arange(N, dtype=jnp.float32)
    return {
        "x": nrm(k[0], (BATCH, SEQ, D), jnp.float32),
        "c": nrm(k[1], (BATCH, D), jnp.float32),
        "ctx": nrm(k[2], (BATCH, CTX_LEN, D), jnp.float32),
        "c_ctx": nrm(k[3], (D,), jnp.float32),
        "ada_w": nrm(k[4], (DEPTH, D, 3 * D), jnp.float32) * (0.5 * D ** -0.5),
        "ada_b": 0.01 * nrm(k[5], (DEPTH, 3 * D), jnp.float32),
        "norm_g": 1.0 + 0.01 * nrm(k[6], (DEPTH, D), jnp.float32),
        "in_w": nrm(k[7], (DEPTH, D, 2 * MIX_WIDTH), jnp.float32) * D ** -0.5,
        "pool_w": nrm(k[8], (DEPTH, POOL_GROUPS, POOL_GROUP_W, POOL_GROUP_W), jnp.float32) * POOL_GROUP_W ** -0.5,
        "pool_scale": 1.0 + 0.1 * nrm(k[9], (DEPTH, POOL_WIDTH), jnp.float32),
        "s5_lam_re": -0.5 + 0.01 * nrm(k[10], (DEPTH, 2, G, N), jnp.float32),
        "s5_lam_im": jnp.pi * n_idx + 0.01 * nrm(k[11], (DEPTH, 2, G, N), jnp.float32),
        "s5_log_dt": jax.random.uniform(k[12], (DEPTH, 2, G), jnp.float32,
                                        minval=math.log(DT_MIN), maxval=math.log(DT_MAX)),
        "s5_b_re": nrm(k[13], (DEPTH, 2, G, N, H), jnp.float32) * (2 * H) ** -0.5,
        "s5_b_im": nrm(k[14], (DEPTH, 2, G, N, H), jnp.float32) * (2 * H) ** -0.5,
        "s5_c_re": nrm(k[15], (DEPTH, 2, G, H, N), jnp.float32) * N ** -0.5,
        "s5_c_im": nrm(k[16], (DEPTH, 2, G, H, N), jnp.float32) * N ** -0.5,
        "s5_d": nrm(k[17], (DEPTH, SSM_WIDTH), jnp.float32),
        "glu_w": nrm(k[18], (DEPTH, SSM_WIDTH, 2 * SSM_WIDTH), jnp.float32) * SSM_WIDTH ** -0.5,
        "glu_b": 0.01 * nrm(k[19], (DEPTH, 2 * SSM_WIDTH), jnp.float32),
        "out_w": nrm(k[20], (DEPTH, MIX_WIDTH, D), jnp.float32) * MIX_WIDTH ** -0.5,
        "final_g": 1.0 + 0.01 * nrm(k[21], (D,), jnp.float32),
    }


def reference(x, c, ctx, c_ctx, ada_w, ada_b, norm_g, in_w, pool_w, pool_scale,
              s5_lam_re, s5_lam_im, s5_log_dt, s5_b_re, s5_b_im, s5_c_re, s5_c_im, s5_d,
              glu_w, glu_b, out_w, final_g):
    for i in range(DEPTH):
        x, ctx = _layer(x, ctx, c, c_ctx, ada_w[i], ada_b[i], norm_g[i], in_w[i], pool_w[i], pool_scale[i],
                        s5_lam_re[i], s5_lam_im[i], s5_log_dt[i], s5_b_re[i], s5_b_im[i],
                        s5_c_re[i], s5_c_im[i], s5_d[i], glu_w[i], glu_b[i], out_w[i],
                        update_ctx=(i < DEPTH - 1))
    return _rmsnorm(x, final_g)
```

```cpp
#include <hip/hip_runtime.h>
#include <cstdint>
#include <cstdio>

#define LAS __attribute__((address_space(3)))
typedef _Float16 f16;
typedef _Float16 f16x8 __attribute__((ext_vector_type(8)));
typedef _Float16 f16x2 __attribute__((ext_vector_type(2)));
typedef float f32x4 __attribute__((ext_vector_type(4)));
typedef float f32x2 __attribute__((ext_vector_type(2)));
typedef unsigned u32x4 __attribute__((ext_vector_type(4)));
typedef unsigned u32x2 __attribute__((ext_vector_type(2)));

__device__ __forceinline__ unsigned pk_f16(float lo, float hi) { f16x2 v; v.x = (f16)lo; v.y = (f16)hi; return __builtin_bit_cast(unsigned, v); }
__device__ __forceinline__ float f16lo(unsigned w) { f16x2 v = __builtin_bit_cast(f16x2, w); return (float)v.x; }
__device__ __forceinline__ float f16hi(unsigned w) { f16x2 v = __builtin_bit_cast(f16x2, w); return (float)v.y; }
__device__ __forceinline__ float fast_sigmoid(float v) { return __builtin_amdgcn_rcpf(1.f + __expf(-v)); }
__device__ __forceinline__ float silu_f(float v) { return v * fast_sigmoid(v); }
__device__ __forceinline__ float gelu_tanh_f(float y) { const float t = 0.7978845608028654f * (y + 0.044715f * y * y * y); return y * fast_sigmoid(2.f * t); }

constexpr int D = 2048, BATCH = 2, SEQ = 8192, CTX = 256, GW = 64, ROWS = SEQ / GW;
constexpr int M_LAT = BATCH * SEQ, M_CTX = BATCH * CTX, M_ALL = M_LAT + M_CTX;
constexpr int PW = 1024, SW = 1024, NG = 64, NS = 64, GH = 16;
constexpr int TC = 32;
constexpr int NLC = M_LAT / TC;
constexpr int NCC = M_CTX / TC;
constexpr int NCH = NLC + NCC;
constexpr int XK = 256 + TC * GH;
constexpr float EPS = 1e-6f;
constexpr int NWAVES = 8, NTHREADS = 512;

constexpr size_t MiB = 1u << 20;
constexpr size_t WS_CTL = 0;
constexpr size_t WS_MOD = 1 * MiB;
constexpr size_t WS_ROWSS = 2 * MiB;
constexpr size_t WS_WIN = 4 * MiB;
constexpr size_t WS_WOUT = 20 * MiB;
constexpr size_t WS_WGLU = 28 * MiB;
constexpr size_t WS_WPOOL = 32 * MiB;
constexpr size_t WS_PG = 33 * MiB;
constexpr size_t WS_MG = 49 * MiB;
constexpr size_t WS_H = 97 * MiB;
constexpr size_t WS_BRANCH = WS_H;
constexpr size_t WS_UPOOL = 163 * MiB;
constexpr size_t WS_X = 195 * MiB;
constexpr size_t WS_ZS = 246 * MiB;
constexpr size_t WS_PM = 310 * MiB;
constexpr size_t WS_S = 342 * MiB;
constexpr size_t WS_YG = 376 * MiB;
constexpr size_t WS_YF = 408 * MiB;
constexpr size_t WS_END = 472 * MiB;
constexpr size_t XGS = (size_t)NCH * XK;
constexpr size_t YGS = (size_t)M_LAT * GH;
constexpr size_t MGS = (size_t)512 * XK;
constexpr size_t PGS = (size_t)256 * 512;

namespace pg8 {
constexpr int BM = 256, BK = 64, HALF = 128, HTB = HALF * BK * 2, STAGE_BYTES = 8 * HTB, NXCD = 8, WGM = 8;
__host__ __device__ __forceinline__ int lds_byte(int r, int c) { const int st = (r >> 4) * 2 + (c >> 5), rr = r & 15, cc = c & 31, ob = rr * 64 + cc * 2; return st * 1024 + (ob ^ (((ob >> 9) & 1) << 5)); }
__host__ __device__ __forceinline__ void stage_rc(int b, int& R, int& C) { const int st = b / 1024, sb = b % 1024, swz = sb ^ (((sb >> 9) & 1) << 5); R = (st >> 1) * 16 + swz / 64; C = (st & 1) * 32 + (swz % 64) / 2; }
__host__ __device__ __forceinline__ int perm32(int rho) { const int n = rho >> 4, i = rho & 15; return 8 * (i >> 2) + 4 * n + (i & 3); }

struct Unit { int pm, pn, g; };
template <int NT_, int AMODE_, unsigned A_ROW_, size_t A_T_, size_t A_H_, size_t A_K_, size_t A_G_, unsigned B_ROW_, size_t B_T_, size_t B_H_, size_t B_K_, size_t B_G_>
struct Cfg { static constexpr int NT = NT_, AMODE = AMODE_; static constexpr unsigned A_ROW = A_ROW_, B_ROW = B_ROW_; static constexpr size_t A_T = A_T_, A_H = A_H_, A_K = A_K_, A_G = A_G_, B_T = B_T_, B_H = B_H_, B_K = B_K_, B_G = B_G_; };

struct DenseOrder {
    int nM, nN, nwg, G, c;
    __device__ void init(int nM_, int nN_, int G_, int c_) { nM = nM_; nN = nN_; nwg = nM * nN; G = G_; c = c_; }
    __device__ bool next(int i, Unit& u) const {
        const long L = (long)i * G + c; if (L >= nwg) return false;
        int wgid = (int)L; { const int q = nwg / NXCD, r = nwg % NXCD, xcd = wgid % NXCD, off = wgid / NXCD; wgid = (xcd < r ? xcd * (q + 1) : r * (q + 1) + (xcd - r) * q) + off; }
        const int nig = WGM * nN, gid = wgid / nig, fm = gid * WGM, gsz = (nM - fm) < WGM ? (nM - fm) : WGM;
        u.pm = fm + ((wgid % nig) % gsz); u.pn = (wgid % nig) / gsz; u.g = 0; return true;
    }
};
struct ListOrder {
    int n, npm, npn, G, vc;
    __device__ void init(int n_, int npm_, int npn_, int G_, int vc_) { n = n_; npm = npm_; npn = npn_; G = G_; vc = vc_; }
    __device__ bool next(int i, Unit& u) const { const int L = i * G + vc; if (L >= n) return false; u.g = L / (npm * npn); u.pm = (L / npn) % npm; u.pn = L % npn; return true; }
};

template <class CF, class Epi, class Sched, bool ALIGN_EPI, bool SP2>
__device__ __forceinline__ void gemm_phase(LAS unsigned char* lds, const char* gA, const char* gB, const Sched& S, const Epi& E) {
    constexpr int AMODE = CF::AMODE;
    const int tid = threadIdx.x, wid = __builtin_amdgcn_readfirstlane(tid >> 6), lane = tid & 63, wr = wid >> 2, wc = wid & 3, fr = lane & 15, fq = lane >> 4;
    constexpr int nt = CF::NT;
    unsigned voffA[2], voffB[2];
#pragma unroll
    for (int i = 0; i < 2; ++i) { int R, C; stage_rc(tid * 16 + i * 8192, R, C); const int Rb = Epi::PERM ? ((R & ~31) + perm32(R & 31)) : R;
        voffA[i] = AMODE == 0 ? (unsigned)R * CF::A_ROW + (unsigned)C * 2u : (unsigned)(C >> 4) * CF::A_ROW + (unsigned)R * 32u + (unsigned)(C & 15) * 2u;
        voffB[i] = (unsigned)Rb * CF::B_ROW + (unsigned)C * 2u; }
    constexpr size_t akstep = CF::A_K, bkstep = CF::B_K, ahstep = CF::A_H, bhstep = CF::B_H;
    const unsigned ldsw = (unsigned)wid * 1024u;
    const int aoff = lds_byte(wr * 64 + fr, fq * 8), boff = lds_byte(wc * 32 + fr, fq * 8);
#define PG8_SA(b, h) (((b) * 2 + (h)) * HTB)
#define PG8_SB(b, h) ((4 + (b) * 2 + (h)) * HTB)
#define PG8_STAGE(bufoff, gbase, voff) do { _Pragma("unroll") for (int _i = 0; _i < 2; ++_i) \
        __builtin_amdgcn_global_load_lds((const unsigned*)((const char*)(gbase) + (voff)[_i]), (LAS unsigned*)(lds + (bufoff) + ldsw + _i * 8192), 16, 0, 0); } while (0)
#define PG8_LDA(dst, b, h) do { _Pragma("unroll") for (int m = 0; m < 4; ++m) _Pragma("unroll") for (int k = 0; k < 2; ++k) dst[m][k] = *(const LAS f16x8*)(lds + PG8_SA(b, h) + aoff + m * 2048 + k * 1024); } while (0)
#define PG8_LDB(dst, b, h) do { _Pragma("unroll") for (int n = 0; n < 2; ++n) _Pragma("unroll") for (int k = 0; k < 2; ++k) dst[n][k] = *(const LAS f16x8*)(lds + PG8_SB(b, h) + boff + n * 2048 + k * 1024); } while (0)
#define PG8_MMA(ai, bj, At, Bt) do { __builtin_amdgcn_s_setprio(1); _Pragma("unroll") for (int m = 0; m < 4; ++m) _Pragma("unroll") for (int n = 0; n < 2; ++n) _Pragma("unroll") for (int k = 0; k < 2; ++k) \
        acc[ai][bj][m][n] = __builtin_amdgcn_mfma_f32_16x16x32_f16(Bt[n][k], At[m][k], acc[ai][bj][m][n], 0, 0, 0); __builtin_amdgcn_s_setprio(0); } while (0)
#define PG8_WAIT_V(n) asm volatile("s_waitcnt vmcnt(" #n ")" ::: "memory")
#define PG8_WAIT_L(n) asm volatile("s_waitcnt lgkmcnt(" #n ")" ::: "memory")
#define PG8_BAR __builtin_amdgcn_s_barrier()
#define PG8_SCHED __builtin_amdgcn_sched_barrier(0)
    Unit cur, nxt; int ui = 0;
    if (!S.next(0, cur)) return;
    f32x4 acc[2][2][4][2];
#pragma unroll
    for (int a = 0; a < 2; ++a)
#pragma unroll
        for (int b = 0; b < 2; ++b)
#pragma unroll
            for (int m = 0; m < 4; ++m)
#pragma unroll
                for (int n = 0; n < 2; ++n) acc[a][b][m][n] = (f32x4){0.f, 0.f, 0.f, 0.f};
    f16x8 At[4][2], B0[2][2], B1[2][2];
    const char* cA = gA + (size_t)cur.g * CF::A_G + (size_t)cur.pm * CF::A_T; const char* cB = gB + (size_t)cur.g * CF::B_G + (size_t)cur.pn * CF::B_T;
    if constexpr (SP2) {
        PG8_STAGE(PG8_SB(0, 0), cB, voffB); PG8_STAGE(PG8_SB(0, 1), cB + bhstep, voffB); PG8_STAGE(PG8_SA(0, 0), cA, voffA); PG8_STAGE(PG8_SA(0, 1), cA + ahstep, voffA);
        if (wr == 1) PG8_BAR;
        PG8_WAIT_V(2); PG8_BAR;
        PG8_STAGE(PG8_SB(1, 0), cB + bkstep, voffB); PG8_STAGE(PG8_SA(1, 0), cA + akstep, voffA); PG8_STAGE(PG8_SB(1, 1), cB + bhstep + bkstep, voffB);
        PG8_WAIT_V(6); PG8_BAR;
    } else {
        PG8_STAGE(PG8_SB(0, 0), cB, voffB); PG8_STAGE(PG8_SA(0, 0), cA, voffA); PG8_STAGE(PG8_SB(0, 1), cB + bhstep, voffB); PG8_STAGE(PG8_SA(0, 1), cA + ahstep, voffA);
        if (wr == 1) PG8_BAR;
        PG8_WAIT_V(4); PG8_BAR;
        PG8_STAGE(PG8_SB(1, 0), cB + bkstep, voffB); PG8_STAGE(PG8_SA(1, 0), cA + akstep, voffA); PG8_STAGE(PG8_SB(1, 1), cB + bhstep + bkstep, voffB);
        PG8_WAIT_V(6); PG8_BAR;
    }
    for (;;) {
        const bool has_next = S.next(ui + 1, nxt);
        const char* nA = has_next ? gA + (size_t)nxt.g * CF::A_G + (size_t)nxt.pm * CF::A_T : cA; const char* nB = has_next ? gB + (size_t)nxt.g * CF::B_G + (size_t)nxt.pn * CF::B_T : cB;
        for (int t = 0; t < nt; t += 2) {
            const bool last = (t == nt - 2);
            const char* a1 = cA + (size_t)(t + 1) * akstep;
            const char* a2 = last ? nA : cA + (size_t)(t + 2) * akstep; const char* b2 = last ? nB : cB + (size_t)(t + 2) * bkstep;
            const char* a3 = a2 + akstep; const char* b3 = b2 + bkstep;
            if constexpr (SP2) {
            PG8_LDB(B0, 0, 0); PG8_LDB(B1, 0, 1); PG8_SCHED; PG8_LDA(At, 0, 0); PG8_STAGE(PG8_SA(1, 1), a1 + ahstep, voffA);
            PG8_WAIT_V(8); PG8_WAIT_L(0); PG8_BAR; PG8_MMA(0, 0, At, B0); PG8_MMA(0, 1, At, B1); PG8_BAR; PG8_SCHED;
            PG8_LDA(At, 0, 1); PG8_STAGE(PG8_SB(0, 0), b2, voffB); PG8_STAGE(PG8_SB(0, 1), b2 + bhstep, voffB); PG8_STAGE(PG8_SA(0, 0), a2, voffA);
            PG8_WAIT_V(8); PG8_WAIT_L(0); PG8_BAR; PG8_MMA(1, 0, At, B0); PG8_MMA(1, 1, At, B1); PG8_BAR; PG8_SCHED;
            PG8_LDB(B0, 1, 0); PG8_LDB(B1, 1, 1); PG8_SCHED; PG8_LDA(At, 1, 0); PG8_STAGE(PG8_SA(0, 1), a2 + ahstep, voffA);
            PG8_WAIT_V(8); PG8_WAIT_L(0); PG8_BAR; PG8_MMA(0, 0, At, B0); PG8_MMA(0, 1, At, B1); PG8_BAR; PG8_SCHED;
            PG8_LDA(At, 1, 1); PG8_STAGE(PG8_SB(1, 0), b3, voffB); PG8_STAGE(PG8_SB(1, 1), b3 + bhstep, voffB); PG8_STAGE(PG8_SA(1, 0), a3, voffA);
            PG8_WAIT_V(8); PG8_WAIT_L(0); PG8_BAR; PG8_MMA(1, 0, At, B0); PG8_MMA(1, 1, At, B1); PG8_BAR; PG8_SCHED;
            } else {
            PG8_LDB(B0, 0, 0); PG8_SCHED; PG8_LDA(At, 0, 0); PG8_STAGE(PG8_SA(1, 1), a1 + ahstep, voffA);
            PG8_WAIT_L(8); PG8_BAR; PG8_WAIT_L(0); PG8_MMA(0, 0, At, B0); PG8_BAR; PG8_SCHED;
            PG8_LDB(B1, 0, 1); PG8_STAGE(PG8_SB(0, 0), b2, voffB);
            PG8_BAR; PG8_WAIT_L(0); PG8_MMA(0, 1, At, B1); PG8_BAR;
            PG8_LDA(At, 0, 1); PG8_STAGE(PG8_SA(0, 0), a2, voffA);
            PG8_BAR; PG8_WAIT_L(0); PG8_MMA(1, 0, At, B0); PG8_BAR; PG8_SCHED;
            PG8_STAGE(PG8_SB(0, 1), b2 + bhstep, voffB);
            PG8_WAIT_V(6); PG8_BAR; PG8_MMA(1, 1, At, B1); PG8_BAR;
            PG8_LDB(B0, 1, 0); PG8_SCHED; PG8_LDA(At, 1, 0); PG8_STAGE(PG8_SA(0, 1), a2 + ahstep, voffA);
            PG8_WAIT_L(8); PG8_BAR; PG8_WAIT_L(0); PG8_MMA(0, 0, At, B0); PG8_BAR; PG8_SCHED;
            PG8_LDB(B1, 1, 1); PG8_STAGE(PG8_SB(1, 0), b3, voffB);
            PG8_BAR; PG8_WAIT_L(0); PG8_MMA(0, 1, At, B1); PG8_BAR;
            PG8_LDA(At, 1, 1); PG8_STAGE(PG8_SA(1, 0), a3, voffA);
            PG8_BAR; PG8_WAIT_L(0); PG8_MMA(1, 0, At, B0); PG8_BAR; PG8_SCHED;
            PG8_STAGE(PG8_SB(1, 1), b3 + bhstep, voffB);
            PG8_WAIT_V(6); PG8_BAR; PG8_MMA(1, 1, At, B1); PG8_BAR;
            }
        }
        if constexpr (ALIGN_EPI) { if (wr == 0) PG8_BAR; }
        E(acc, cur, wr, wc, fr, fq);
        if (!has_next) break;
#pragma unroll
        for (int a = 0; a < 2; ++a)
#pragma unroll
            for (int b = 0; b < 2; ++b)
#pragma unroll
                for (int m = 0; m < 4; ++m)
#pragma unroll
                    for (int n = 0; n < 2; ++n) acc[a][b][m][n] = (f32x4){0.f, 0.f, 0.f, 0.f};
        cur = nxt; cA = nA; cB = nB; ++ui;
        if constexpr (ALIGN_EPI) { if (wr == 1) PG8_BAR; }
    }
    PG8_WAIT_V(0);
    if constexpr (!ALIGN_EPI) { if (wr == 0) PG8_BAR; }
    PG8_BAR;
#undef PG8_SA
#undef PG8_SB
#undef PG8_STAGE
#undef PG8_LDA
#undef PG8_LDB
#undef PG8_MMA
#undef PG8_WAIT_V
#undef PG8_WAIT_L
#undef PG8_BAR
#undef PG8_SCHED
}
}
using pg8::Unit;
using pg8::HALF;
typedef const f32x4 (&AccRef)[2][2][4][2];

__device__ __forceinline__ u32x4 pack8(const f32x4 v0, const f32x4 v1) { u32x4 w; w.x = pk_f16(v0[0], v0[1]); w.y = pk_f16(v0[2], v0[3]); w.z = pk_f16(v1[0], v1[1]); w.w = pk_f16(v1[2], v1[3]); return w; }
__device__ __forceinline__ void unpack8(const u32x4 w, f32x4& v0, f32x4& v1) { v0 = (f32x4){f16lo(w.x), f16hi(w.x), f16lo(w.y), f16hi(w.y)}; v1 = (f32x4){f16lo(w.z), f16hi(w.z), f16lo(w.w), f16hi(w.w)}; }

struct EpiInProj {
    static constexpr bool PERM = true;
    f16* upool; f16* X; f16* zs;
    __device__ __forceinline__ void operator()(AccRef acc, const Unit& u, int wr, int wc, int fr, int fq) const {
        const int row0 = u.pm * 256 + wr * 64 + fr, col0 = u.pn * 256 + wc * 32 + 8 * fq;
#pragma unroll
        for (int ai = 0; ai < 2; ++ai)
#pragma unroll
            for (int m = 0; m < 4; ++m) { const int row = row0 + ai * HALF + m * 16;
#pragma unroll
                for (int bj = 0; bj < 2; ++bj) { const int col = col0 + bj * HALF; f32x4 v0 = acc[ai][bj][m][0], v1 = acc[ai][bj][m][1];
                    if (u.pn < 4) { *(u32x4*)(upool + (size_t)row * PW + col) = pack8(v0, v1); }
                    else if (u.pn < 8) { const int cs = col - PW, gg = cs >> 4, hh = cs & 15, lc = row >> 5, s = row & 31;
                        *(u32x4*)(X + (size_t)gg * XGS + (size_t)lc * XK + 256 + s * 16 + hh) = pack8(v0, v1); }
                    else {
#pragma unroll
                        for (int j = 0; j < 4; ++j) { v0[j] = silu_f(v0[j]); v1[j] = silu_f(v1[j]); }
                        *(u32x4*)(zs + (size_t)row * D + (col - PW - SW)) = pack8(v0, v1); } } }
    }
};
struct EpiCtx {
    static constexpr bool PERM = true;
    f16* X;
    __device__ __forceinline__ void operator()(AccRef acc, const Unit& u, int wr, int wc, int fr, int fq) const {
        const int row0 = u.pm * 256 + wr * 64 + fr, col0 = u.pn * 256 + wc * 32 + 8 * fq;
#pragma unroll
        for (int ai = 0; ai < 2; ++ai)
#pragma unroll
            for (int m = 0; m < 4; ++m) { const int row = row0 + ai * HALF + m * 16;
#pragma unroll
                for (int bj = 0; bj < 2; ++bj) { const int cs = col0 + bj * HALF, gg = cs >> 4, hh = cs & 15, lc = NLC + (row >> 5), s = row & 31;
                    *(u32x4*)(X + (size_t)gg * XGS + (size_t)lc * XK + 256 + s * 16 + hh) = pack8(acc[ai][bj][m][0], acc[ai][bj][m][1]); } }
    }
};
struct EpiPool {
    static constexpr bool PERM = true;
    f16* branch; const f16* zs; const float* pscale;
    __device__ __forceinline__ void operator()(AccRef acc, const Unit& u, int wr, int wc, int fr, int fq) const {
        const int row0 = u.pm * 256 + wr * 64 + fr, col0 = u.g * 256 + wc * 32 + 8 * fq;
        f32x4 sc[2][2];
#pragma unroll
        for (int bj = 0; bj < 2; ++bj) { sc[bj][0] = *(const f32x4*)(pscale + col0 + bj * HALF); sc[bj][1] = *(const f32x4*)(pscale + col0 + bj * HALF + 4); }
#pragma unroll
        for (int ai = 0; ai < 2; ++ai)
#pragma unroll
            for (int m = 0; m < 4; ++m) { const int row = row0 + ai * HALF + m * 16;
#pragma unroll
                for (int bj = 0; bj < 2; ++bj) { const size_t o = (size_t)row * D + col0 + bj * HALF; f32x4 z0, z1; unpack8(*(const u32x4*)(zs + o), z0, z1);
                    *(u32x4*)(branch + o) = pack8(acc[ai][bj][m][0] * sc[bj][0] * z0, acc[ai][bj][m][1] * sc[bj][1] * z1); } }
    }
};
struct EpiS {
    static constexpr bool PERM = false;
    float* S;
    __device__ __forceinline__ void operator()(AccRef acc, const Unit& u, int wr, int wc, int fr, int fq) const {
        const int row0 = u.pm * 256 + wr * 64 + fr, col0 = wc * 32 + 4 * fq;
#pragma unroll
        for (int ai = 0; ai < 2; ++ai)
#pragma unroll
            for (int m = 0; m < 4; ++m) { const int row = row0 + ai * HALF + m * 16;
                if (row < NCH) { float* rp = S + ((size_t)u.g * NCH + row) * 256 + col0;
#pragma unroll
                    for (int bj = 0; bj < 2; ++bj)
#pragma unroll
                        for (int n = 0; n < 2; ++n) *(f32x4*)(rp + bj * HALF + n * 16) = acc[ai][bj][m][n]; } }
    }
};
struct EpiY {
    static constexpr bool PERM = true;
    f16* YG; const f16* X; const float* dskip;
    __device__ __forceinline__ void operator()(AccRef acc, const Unit& u, int wr, int wc, int fr, int fq) const {
        const int row0 = u.pm * 256 + wr * 64 + fr, col0 = u.pn * 256 + wc * 32 + 8 * fq;
        const float* dp = dskip + u.g * GH + (col0 & 15);
        const f32x4 d0 = *(const f32x4*)dp, d1 = *(const f32x4*)(dp + 4);
#pragma unroll
        for (int ai = 0; ai < 2; ++ai)
#pragma unroll
            for (int m = 0; m < 4; ++m) { const int lc = row0 + ai * HALF + m * 16;
#pragma unroll
                for (int bj = 0; bj < 2; ++bj) { const int n0 = col0 + bj * HALF; f32x4 u0, u1; unpack8(*(const u32x4*)(X + (size_t)u.g * XGS + (size_t)lc * XK + 256 + n0), u0, u1);
                    f32x4 v0 = acc[ai][bj][m][0] + d0 * u0, v1 = acc[ai][bj][m][1] + d1 * u1;
#pragma unroll
                    for (int j = 0; j < 4; ++j) { v0[j] = gelu_tanh_f(v0[j]); v1[j] = gelu_tanh_f(v1[j]); }
                    *(u32x4*)(YG + (size_t)u.g * YGS + (size_t)lc * 512 + n0) = pack8(v0, v1); } }
    }
};
struct EpiGlu {
    static constexpr bool PERM = true;
    f16* branch; const f16* zs; const float* gb;
    __device__ __forceinline__ void operator()(AccRef acc, const Unit& u, int wr, int wc, int fr, int fq) const {
        const int row0 = u.pm * 256 + wr * 64 + fr, col0 = u.pn * 128 + wc * 32 + 8 * fq;
        const f32x4 b10 = *(const f32x4*)(gb + col0), b11 = *(const f32x4*)(gb + col0 + 4), b20 = *(const f32x4*)(gb + SW + col0), b21 = *(const f32x4*)(gb + SW + col0 + 4);
#pragma unroll
        for (int ai = 0; ai < 2; ++ai)
#pragma unroll
            for (int m = 0; m < 4; ++m) { const int row = row0 + ai * HALF + m * 16; const size_t o = (size_t)row * D + PW + col0;
                f32x4 z0, z1; unpack8(*(const u32x4*)(zs + o), z0, z1);
                f32x4 y10 = acc[ai][0][m][0] + b10, y11 = acc[ai][0][m][1] + b11, y20 = acc[ai][1][m][0] + b20, y21 = acc[ai][1][m][1] + b21;
#pragma unroll
                for (int j = 0; j < 4; ++j) { y10[j] = y10[j] * fast_sigmoid(y20[j]) * z0[j]; y11[j] = y11[j] * fast_sigmoid(y21[j]) * z1[j]; }
                *(u32x4*)(branch + o) = pack8(y10, y11); }
    }
};
struct EpiOut {
    static constexpr bool PERM = false;
    const float* x; float* out; const float* mod; float* rowss;
    __device__ __forceinline__ void operator()(AccRef acc, const Unit& u, int wr, int wc, int fr, int fq) const {
        const int row0 = u.pm * 256 + wr * 64 + fr, col0 = u.pn * 256 + wc * 32 + 4 * fq;
        const float* gate = mod + (size_t)(u.pm >= 32 ? 1 : 0) * 3 * D + 2 * D + col0;
        f32x4 gv[2][2];
#pragma unroll
        for (int bj = 0; bj < 2; ++bj)
#pragma unroll
            for (int n = 0; n < 2; ++n) gv[bj][n] = *(const f32x4*)(gate + bj * HALF + n * 16);
#pragma unroll
        for (int ai = 0; ai < 2; ++ai)
#pragma unroll
            for (int m = 0; m < 4; ++m) { const int row = row0 + ai * HALF + m * 16; const size_t o = (size_t)row * D + col0; float ss = 0.f;
#pragma unroll
                for (int bj = 0; bj < 2; ++bj)
#pragma unroll
                    for (int n = 0; n < 2; ++n) { const f32x4 xv = *(const f32x4*)(x + o + bj * HALF + n * 16); const f32x4 r = xv + gv[bj][n] * acc[ai][bj][m][n];
                        *(f32x4*)(out + o + bj * HALF + n * 16) = r; ss += (r[0] * r[0] + r[1] * r[1]) + (r[2] * r[2] + r[3] * r[3]); }
                ss += __shfl_xor(ss, 16); ss += __shfl_xor(ss, 32);
                if (fq == 0) rowss[(size_t)row * 32 + u.pn * 4 + wc] = ss;
                asm volatile("" ::: "memory"); }
    }
};

constexpr int LDS_BYTES = 147456;

struct Args { const float* in[22]; float* out; unsigned char* ws; int ph_lo, ph_hi; };

constexpr int T_AP = 0, T_BR = T_AP + 2 * 33 * 64 * 2, T_BI = T_BR + 2 * 64 * 16, T_CR = T_BI + 2 * 64 * 16, T_CI = T_CR + 2 * 16 * 64, T_KT = T_CI + 2 * 16 * 64, T_END = T_KT + 2 * 32 * 256;
static_assert(T_END * 4 <= 147456, "tables LDS");
__device__ __forceinline__ void ssm_tables(LAS float* L, int g, const float* lam_re, const float* lam_im, const float* log_dt, const float* b_re, const float* b_im,
                                           const float* c_re, const float* c_im, f16* PGg, f16* MGg) {
    const int tid = threadIdx.x;
    for (int i = tid; i < 2 * 33 * 64; i += NTHREADS) { const int dir = i / (33 * 64), j = (i / 64) % 33, n = i % 64; const int pg = dir * NG + g;
        const float dt = expf(log_dt[pg]), lr = lam_re[pg * NS + n], li = lam_im[pg * NS + n];
        const float er = expf((float)j * lr * dt); float sn, cs; sincosf((float)j * (li * dt), &sn, &cs);
        L[T_AP + i * 2] = er * cs; L[T_AP + i * 2 + 1] = er * sn; }
    for (int i = tid; i < 2 * 64 * 16; i += NTHREADS) { const int dir = i / 1024, n = (i / 16) % 64, h = i % 16; const int pg = dir * NG + g;
        const float dt = expf(log_dt[pg]), lr = lam_re[pg * NS + n], li = lam_im[pg * NS + n];
        const float th = li * dt; float sn, cs; sincosf(th, &sn, &cs); const float sh = sinf(0.5f * th);
        const float em1 = expm1f(lr * dt), er = em1 + 1.f;
        const float nr = em1 * cs - 2.f * sh * sh, ni = er * sn, den = lr * lr + li * li;
        const float qr = (nr * lr + ni * li) / den, qi = (ni * lr - nr * li) / den;
        const float br = b_re[((size_t)pg * NS + n) * GH + h], bi = b_im[((size_t)pg * NS + n) * GH + h];
        L[T_BR + i] = qr * br - qi * bi; L[T_BI + i] = qr * bi + qi * br; }
    for (int i = tid; i < 2 * 16 * 64; i += NTHREADS) { const int dir = i / 1024, r = i % 1024; const int pg = dir * NG + g;
        L[T_CR + i] = c_re[(size_t)pg * 1024 + r]; L[T_CI + i] = c_im[(size_t)pg * 1024 + r]; }
    __syncthreads();
#pragma unroll 1
    for (int dir = 0; dir < 2; ++dir) { const int j = tid >> 4, h = tid & 15;
        float acc[16];
#pragma unroll
        for (int q = 0; q < 16; ++q) acc[q] = 0.f;
#pragma unroll 2
        for (int n = 0; n < 64; ++n) {
            const float cr = L[T_CR + dir * 1024 + h * 64 + n], ci = L[T_CI + dir * 1024 + h * 64 + n];
            const float pr = L[T_AP + ((dir * 33 + j) * 64 + n) * 2], pi = L[T_AP + ((dir * 33 + j) * 64 + n) * 2 + 1];
            const float car = cr * pr - ci * pi, cai = cr * pi + ci * pr;
            const LAS f32x4* brp = (const LAS f32x4*)(L + T_BR + dir * 1024 + n * 16); const LAS f32x4* bip = (const LAS f32x4*)(L + T_BI + dir * 1024 + n * 16);
#pragma unroll
            for (int q = 0; q < 4; ++q) { const f32x4 bv = brp[q], iv = bip[q];
#pragma unroll
                for (int e = 0; e < 4; ++e) acc[q * 4 + e] += car * bv[e] - cai * iv[e]; }
        }
#pragma unroll
        for (int q = 0; q < 16; ++q) L[T_KT + ((dir * 32 + j) * 16 + h) * 16 + q] = acc[q];
    }
    __syncthreads();
    for (int i = tid; i < 256 * 64; i += NTHREADS) { const int jrow = i >> 6, k0 = (i & 63) * 8; const int dir = jrow >> 7, ri = (jrow >> 6) & 1, n = jrow & 63, sp = k0 >> 4, h0 = k0 & 15;
        const int e = dir == 0 ? TC - 1 - sp : sp;
        const float pr = L[T_AP + ((dir * 33 + e) * 64 + n) * 2], pi = L[T_AP + ((dir * 33 + e) * 64 + n) * 2 + 1];
        float v[8];
#pragma unroll
        for (int q = 0; q < 8; ++q) { const float br = L[T_BR + dir * 1024 + n * 16 + h0 + q], bi = L[T_BI + dir * 1024 + n * 16 + h0 + q]; v[q] = ri == 0 ? pr * br - pi * bi : pr * bi + pi * br; }
        u32x4 w; w.x = pk_f16(v[0], v[1]); w.y = pk_f16(v[2], v[3]); w.z = pk_f16(v[4], v[5]); w.w = pk_f16(v[6], v[7]);
        *(u32x4*)(PGg + (size_t)jrow * 512 + k0) = w; }
    for (int i = tid; i < 512 * 96; i += NTHREADS) { const int nrow = i / 96, k0 = (i % 96) * 8; const int s = nrow >> 4, h = nrow & 15;
        float v[8];
        if (k0 < 256) { const int dir = k0 >> 7, ri = (k0 >> 6) & 1, n0 = k0 & 63; const int e = dir == 0 ? s + 1 : TC - s;
#pragma unroll
            for (int q = 0; q < 8; ++q) { const float cr = L[T_CR + dir * 1024 + h * 64 + n0 + q], ci = L[T_CI + dir * 1024 + h * 64 + n0 + q];
                const float pr = L[T_AP + ((dir * 33 + e) * 64 + n0 + q) * 2], pi = L[T_AP + ((dir * 33 + e) * 64 + n0 + q) * 2 + 1];
                v[q] = ri == 0 ? cr * pr - ci * pi : -(cr * pi + ci * pr); }
        } else { const int kk = k0 - 256, sp = kk >> 4, h0 = kk & 15;
#pragma unroll
            for (int q = 0; q < 8; ++q) {
                const float kf = L[T_KT + ((0 * 32 + (sp < s ? s - sp : 0)) * 16 + h) * 16 + h0 + q], kb = L[T_KT + ((1 * 32 + (sp > s ? sp - s : 0)) * 16 + h) * 16 + h0 + q];
                v[q] = sp < s ? kf : (sp > s ? kb : kf + kb); }
        }
        u32x4 w; w.x = pk_f16(v[0], v[1]); w.y = pk_f16(v[2], v[3]); w.z = pk_f16(v[4], v[5]); w.w = pk_f16(v[6], v[7]);
        *(u32x4*)(MGg + (size_t)nrow * XK + k0) = w; }
    __syncthreads();
}
__device__ __forceinline__ void ssm_scan(LAS float* L, int item, const float* lam_re, const float* lam_im, const float* log_dt, const float* S, f16* X) {
    const int b = item >> 7, dir = (item >> 6) & 1, g = item & 63;
    const int tid = threadIdx.x, seg = tid >> 6, n = tid & 63, pg = dir * NG + g;
    const float dt = expf(log_dt[pg]), lr = lam_re[pg * NS + n], li = lam_im[pg * NS + n];
    float tr, ti, sr, si;
    { const float er = expf((float)TC * lr * dt); float sn, cs; sincosf((float)TC * (li * dt), &sn, &cs); tr = er * cs; ti = er * sn; }
    { const float er = expf((float)(33 * TC) * lr * dt); float sn, cs; sincosf((float)(33 * TC) * (li * dt), &sn, &cs); sr = er * cs; si = er * sn; }
    const float* Sg = S + (size_t)g * NCH * 256 + dir * 128 + n;
    f16* Xg = X + (size_t)g * XGS + dir * 128 + n;
    float vr[33], vi[33];
#pragma unroll
    for (int i = 0; i < 33; ++i) { const int p = seg * 33 + i;
        const int row = p < 8 ? NLC + b * 8 + (dir == 0 ? p : 7 - p) : b * 256 + (dir == 0 ? p - 8 : 255 - (p - 8));
        vr[i] = Sg[(size_t)row * 256]; vi[i] = Sg[(size_t)row * 256 + 64]; }
    float hr = 0.f, hi = 0.f;
#pragma unroll
    for (int i = 0; i < 33; ++i) { const float s_r = vr[i], s_i = vi[i]; vr[i] = hr; vi[i] = hi; const float nr = tr * hr - ti * hi + s_r, ni = tr * hi + ti * hr + s_i; hr = nr; hi = ni; }
    L[(seg * 64 + n) * 2] = hr; L[(seg * 64 + n) * 2 + 1] = hi;
    __syncthreads();
    float ir = 0.f, ii = 0.f;
    for (int k = 0; k < seg; ++k) { const float er = L[(k * 64 + n) * 2], ei = L[(k * 64 + n) * 2 + 1]; const float nr = sr * ir - si * ii + er, ni = sr * ii + si * ir + ei; ir = nr; ii = ni; }
    float pr = 1.f, pi = 0.f;
#pragma unroll
    for (int i = 0; i < 33; ++i) { const int p = seg * 33 + i;
        const float fr_ = vr[i] + pr * ir - pi * ii, fi_ = vi[i] + pr * ii + pi * ir;
        if (p >= 8) { const int row = b * 256 + (dir == 0 ? p - 8 : 255 - (p - 8)); Xg[(size_t)row * XK] = (f16)fr_; Xg[(size_t)row * XK + 64] = (f16)fi_; }
        const float npr = pr * tr - pi * ti, npi = pr * ti + pi * tr; pr = npr; pi = npi; }
    __syncthreads();
}

#define XB_TMO      128
#define XB_XCNT(j)  (256  + 64 * (j))
#define XB_XSUB(j)  (1280 + 64 * (j))
#define XB_XGEN(j)  (2304 + 64 * (j))
#define XB_TOP      3328
#define XB_TOPGEN   3392
#define XCD_BAR_WORDS 3456
#define XB_SPIN_CAP (1u << 18)
__device__ __forceinline__ unsigned xb_ld(unsigned* p)              { return __hip_atomic_load(p, __ATOMIC_RELAXED, __HIP_MEMORY_SCOPE_AGENT); }
__device__ __forceinline__ unsigned xb_add(unsigned* p, unsigned v) { return __hip_atomic_fetch_add(p, v, __ATOMIC_RELAXED, __HIP_MEMORY_SCOPE_AGENT); }
__device__ __forceinline__ unsigned xb_xcc_id() { return (unsigned)__builtin_amdgcn_s_getreg((3 << 11) | 20) & 0xFu; }
#define XB_SPIN(cond, bar) do { unsigned _sp = 0; while (cond) { __builtin_amdgcn_s_sleep(1); \
    if ((++_sp & 255u) == 0u) { if (xb_ld(&(bar)[XB_TMO])) break; if (_sp > XB_SPIN_CAP) { atomicAdd(&(bar)[XB_TMO], 1u); break; } } } } while (0)
struct XcdBarrier { unsigned* bar; unsigned x; volatile LAS unsigned* st; };
__device__ __forceinline__ XcdBarrier xcd_barrier_post(unsigned* bar, volatile LAS unsigned* st) {
    XcdBarrier b; b.bar = bar; b.x = xb_xcc_id(); b.st = st;
    if (threadIdx.x == 0) (void)xb_add(&bar[XB_XCNT(b.x)], 1u);
    return b;
}
__device__ __forceinline__ void xcd_barrier_complete(unsigned* bar, unsigned x, unsigned& nloc, unsigned& nx) {
    const unsigned G = gridDim.x * gridDim.y * gridDim.z;
    unsigned sum, cnt, mine, sp = 0u;
    for (;;) {
        sum = 0u; cnt = 0u; mine = 0u;
#pragma unroll
        for (unsigned j = 0; j < 16; ++j) { const unsigned c = xb_ld(&bar[XB_XCNT(j)]); sum += c; cnt += (c > 0u) ? 1u : 0u; mine = (j == x) ? c : mine; }
        if (sum == G) break;
        __builtin_amdgcn_s_sleep(1);
        if ((++sp & 255u) == 0u) { if (xb_ld(&bar[XB_TMO])) break; if (sp > XB_SPIN_CAP) { atomicAdd(&bar[XB_TMO], 1u); break; } }
    }
    nloc = mine > 0u ? mine : 1u; nx = cnt > 0u ? cnt : 1u;
}
__device__ __forceinline__ void xcd_barrier(const XcdBarrier& b) {
    asm volatile("s_waitcnt vmcnt(0)" ::: "memory");
    __syncthreads();
    if (threadIdx.x == 0) {
        unsigned* bar = b.bar;
        __builtin_amdgcn_s_waitcnt(0);
        unsigned nloc = b.st[0], nx = b.st[1];
        if (nloc == 0u) { xcd_barrier_complete(bar, b.x, nloc, nx); b.st[0] = nloc; b.st[1] = nx; }
        const unsigned old = xb_add(&bar[XB_XSUB(b.x)], 1u);
        const unsigned gen = old / nloc;
        if (old + 1u == (gen + 1u) * nloc) {
            __builtin_amdgcn_fence(__ATOMIC_RELEASE, "agent");
            asm volatile("s_waitcnt vmcnt(0)" ::: "memory");
            const unsigned og = xb_add(&bar[XB_TOP], 1u);
            const unsigned tg = og / nx;
            if (og + 1u == (tg + 1u) * nx) xb_add(&bar[XB_TOPGEN], 1u);
            else XB_SPIN(xb_ld(&bar[XB_TOPGEN]) == tg, bar);
            __builtin_amdgcn_fence(__ATOMIC_ACQUIRE, "agent");
            xb_add(&bar[XB_XGEN(b.x)], 1u);
            asm volatile("s_waitcnt vmcnt(0)" ::: "memory");
        } else {
            XB_SPIN(xb_ld(&bar[XB_XGEN(b.x)]) == gen, bar);
            __builtin_amdgcn_fence(__ATOMIC_ACQUIRE, "agent");
            asm volatile("s_waitcnt vmcnt(0)" ::: "memory");
        }
    }
    __syncthreads();
}
__device__ __forceinline__ int q_pop(unsigned* q, volatile LAS int* slot) {
    __syncthreads();
    if (threadIdx.x == 0) *slot = (int)__hip_atomic_fetch_add(q, 1u, __ATOMIC_RELAXED, __HIP_MEMORY_SCOPE_AGENT);
    __syncthreads();
    return *slot;
}
__device__ __forceinline__ float wave_sum(float v) {
#pragma unroll
    for (int o = 1; o < 64; o <<= 1) v += __shfl_xor(v, o);
    return v;
}

__device__ __forceinline__ void gemv_item(LAS float* L, int item, const float* c, const float* c_ctx, const float* ada_w, const float* ada_b, float* mod) {
    const int tid = threadIdx.x, wave = tid >> 6;
    for (int i = tid; i < 3 * D; i += NTHREADS) { const int r = i / D, k = i % D; const float v = r < 2 ? c[r * D + k] : c_ctx[k]; L[i] = v / (1.f + expf(-v)); }
    __syncthreads();
    const int l8 = tid & 7, rs = tid >> 3, n0 = item * 32;
    const float* wp = ada_w + n0 + 4 * l8;
    f32x4 a0 = {0.f, 0.f, 0.f, 0.f}, a1 = a0, a2 = a0;
#pragma unroll 8
    for (int i = 0; i < 32; ++i) { const int k = rs + 64 * i; const f32x4 w = *(const f32x4*)(wp + (size_t)k * (3 * D));
        a0 += L[k] * w; a1 += L[D + k] * w; a2 += L[2 * D + k] * w; }
#pragma unroll
    for (int e = 0; e < 4; ++e) {
#pragma unroll
        for (int o = 8; o < 64; o <<= 1) { a0[e] += __shfl_xor(a0[e], o); a1[e] += __shfl_xor(a1[e], o); a2[e] += __shfl_xor(a2[e], o); } }
    LAS float* red = L + 3 * D;
    if ((tid & 63) < 8) {
#pragma unroll
        for (int e = 0; e < 4; ++e) { red[wave * 96 + l8 * 4 + e] = a0[e]; red[wave * 96 + 32 + l8 * 4 + e] = a1[e]; red[wave * 96 + 64 + l8 * 4 + e] = a2[e]; } }
    __syncthreads();
    if (tid < 96) { float sum = 0.f;
#pragma unroll
        for (int w = 0; w < 8; ++w) sum += red[w * 96 + tid];
        const int r = tid >> 5, col = tid & 31; mod[r * 3 * D + n0 + col] = sum + ada_b[n0 + col]; }
    __syncthreads();
}
__device__ __forceinline__ void transpose_item(const float* W, int K, int N, f16* WT, LAS float* scr, int item, int lane) {
    const int nblk = N / 32, kb = item / nblk, nb = item % nblk, k0 = 64 * kb, n0 = 32 * nb;
#pragma unroll 8
    for (int i = 0; i < 32; ++i) { const int kk = 2 * i + (lane >> 5); scr[kk * 33 + (lane & 31)] = W[(size_t)(k0 + kk) * N + n0 + (lane & 31)]; }
    asm volatile("s_waitcnt lgkmcnt(0)" ::: "memory");
    const int c = lane & 7;
#pragma unroll
    for (int j = 0; j < 4; ++j) { const int n = (lane >> 3) + 8 * j; const LAS float* sp = scr + (8 * c) * 33 + n;
        u32x4 o; o.x = pk_f16(sp[0 * 33], sp[1 * 33]); o.y = pk_f16(sp[2 * 33], sp[3 * 33]); o.z = pk_f16(sp[4 * 33], sp[5 * 33]); o.w = pk_f16(sp[6 * 33], sp[7 * 33]);
        *(u32x4*)(WT + (size_t)(n0 + n) * K + k0 + 8 * c) = o; }
    asm volatile("s_waitcnt lgkmcnt(0)" ::: "memory");
}
constexpr int TI_IN = (D / 64) * (4096 / 32), TI_OUT = (D / 64) * (D / 32), TI_GLU = (SW / 64) * (2 * SW / 32), TI_POOL1 = (256 / 64) * (256 / 32), TI_ALL = TI_IN + TI_OUT + TI_GLU + 4 * TI_POOL1;
__device__ __forceinline__ void transpose_dispatch(int it, const float* in_w, const float* out_w, const float* glu_w, const float* pool_w, unsigned char* ws, LAS float* scr, int lane) {
    if (it < TI_IN) { transpose_item(in_w, D, 4096, (f16*)(ws + WS_WIN), scr, it, lane); return; } it -= TI_IN;
    if (it < TI_OUT) { transpose_item(out_w, D, D, (f16*)(ws + WS_WOUT), scr, it, lane); return; } it -= TI_OUT;
    if (it < TI_GLU) { transpose_item(glu_w, SW, 2 * SW, (f16*)(ws + WS_WGLU), scr, it, lane); return; } it -= TI_GLU;
    const int pg = it / TI_POOL1; transpose_item(pool_w + pg * 65536, 256, 256, (f16*)(ws + WS_WPOOL) + pg * 65536, scr, it % TI_POOL1, lane);
}
__device__ __forceinline__ void norm_rows(int gw, int lane, const float* x, const float* ctx, const float* ng, const float* mod, f16* h) {
    f32x4 gs[8], sh[8];
    auto load_mod = [&](int mr) { const float* shp = mod + mr * 3 * D;
#pragma unroll
        for (int j = 0; j < 8; ++j) { const int cidx = 256 * j + 4 * lane; const f32x4 g4 = *(const f32x4*)(ng + cidx), s4 = *(const f32x4*)(shp + D + cidx); gs[j] = g4 * (1.f + s4); sh[j] = *(const f32x4*)(shp + cidx); } };
    auto do_row = [&](const float* src, f16* dst) { f32x4 v[8]; float ss = 0.f;
#pragma unroll
        for (int j = 0; j < 8; ++j) { v[j] = *(const f32x4*)(src + 256 * j + 4 * lane); ss += (v[j][0] * v[j][0] + v[j][1] * v[j][1]) + (v[j][2] * v[j][2] + v[j][3] * v[j][3]); }
        const float rstd = rsqrtf(wave_sum(ss) * (1.f / D) + EPS);
#pragma unroll
        for (int j = 0; j < 8; ++j) { const f32x4 o = v[j] * rstd * gs[j] + sh[j]; u32x2 w; w.x = pk_f16(o[0], o[1]); w.y = pk_f16(o[2], o[3]); *(u32x2*)(dst + 256 * j + 4 * lane) = w; } };
    const int r0 = gw * 8;
    if (r0 < M_LAT) { load_mod(r0 / SEQ);
        for (int r = r0; r < r0 + 8; ++r) do_row(x + (size_t)r * D, h + (size_t)r * D); }
    if (gw < M_CTX) { load_mod(2); do_row(ctx + (size_t)gw * D, h + (size_t)(M_LAT + gw) * D); }
}
typedef float f32x16 __attribute__((ext_vector_type(16)));
__device__ __forceinline__ void ctx_item(LAS float* L, int item, const f16* hc, const f16* Wssm, f16* X) {
    const int tid = threadIdx.x, wave = tid >> 6, lane = tid & 63, rb = item >> 4, cb = item & 15, k0 = wave * 256 + 8 * (lane >> 5);
    const f16* ap = hc + (size_t)(rb * 32 + (lane & 31)) * D + k0;
    const f16* bp0 = Wssm + (size_t)(cb * 64 + (lane & 31)) * D + k0; const f16* bp1 = bp0 + (size_t)32 * D;
    f32x16 acc0, acc1;
#pragma unroll
    for (int i = 0; i < 16; ++i) { acc0[i] = 0.f; acc1[i] = 0.f; }
#pragma unroll 4
    for (int ks = 0; ks < 16; ++ks) { const f16x8 av = *(const f16x8*)(ap + ks * 16), b0 = *(const f16x8*)(bp0 + ks * 16), b1 = *(const f16x8*)(bp1 + ks * 16);
        acc0 = __builtin_amdgcn_mfma_f32_32x32x16_f16(av, b0, acc0, 0, 0, 0); acc1 = __builtin_amdgcn_mfma_f32_32x32x16_f16(av, b1, acc1, 0, 0, 0); }
#pragma unroll
    for (int r = 0; r < 16; ++r) { L[((wave * 2 + 0) * 16 + r) * 64 + lane] = acc0[r]; L[((wave * 2 + 1) * 16 + r) * 64 + lane] = acc1[r]; }
    __syncthreads();
#pragma unroll
    for (int i = 0; i < 4; ++i) { const int idx = tid + NTHREADS * i, ln = idx & 63, reg = (idx >> 6) & 15, t = idx >> 10; float sum = 0.f;
#pragma unroll
        for (int w = 0; w < 8; ++w) sum += L[((w * 2 + t) * 16 + reg) * 64 + ln];
        const int row = (reg & 3) + 8 * (reg >> 2) + 4 * (ln >> 5), ch = cb * 64 + t * 32 + (ln & 31);
        X[(size_t)(ch >> 4) * XGS + (size_t)(NLC + rb) * XK + 256 + row * 16 + (ch & 15)] = (f16)sum; }
    __syncthreads();
}
__device__ __forceinline__ void pm_item(LAS float* Vs, int item, const f16* up, f16* pm) {
    const int tid = threadIdx.x, b = item >> 7, g = (item >> 5) & 3, band = item & 31, r0 = band * 4;
    const int w = 2 << g, lo_off = w >> 1, hi_off = w - lo_off;
    const int o = tid & 31, cs = tid >> 5;
    const size_t cbase = (size_t)b * SEQ * PW + g * 256 + o * 8;
    float rs[4][8];
#pragma unroll
    for (int q = 0; q < 4; ++q)
#pragma unroll
        for (int e = 0; e < 8; ++e) rs[q][e] = 0.f;
    int cur_lo = r0 - lo_off < 0 ? 0 : r0 - lo_off, cur_hi = cur_lo;
    for (int r = r0; r < r0 + 4; ++r) {
        const int rlo = r - lo_off < 0 ? 0 : r - lo_off, rhi = r + hi_off > ROWS ? ROWS : r + hi_off;
        for (; cur_hi < rhi; ++cur_hi) {
#pragma unroll
            for (int q = 0; q < 4; ++q) { f32x4 v0, v1; unpack8(*(const u32x4*)(up + cbase + (size_t)(cur_hi * GW + cs + 16 * q) * PW), v0, v1);
#pragma unroll
                for (int e = 0; e < 4; ++e) { rs[q][e] += v0[e]; rs[q][4 + e] += v1[e]; } } }
        for (; cur_lo < rlo; ++cur_lo) {
#pragma unroll
            for (int q = 0; q < 4; ++q) { f32x4 v0, v1; unpack8(*(const u32x4*)(up + cbase + (size_t)(cur_lo * GW + cs + 16 * q) * PW), v0, v1);
#pragma unroll
                for (int e = 0; e < 4; ++e) { rs[q][e] -= v0[e]; rs[q][4 + e] -= v1[e]; } } }
        const float inv = 1.f / (float)(rhi - rlo);
#pragma unroll
        for (int q = 0; q < 4; ++q) { LAS f32x4* vp = (LAS f32x4*)(Vs + (cs + 16 * q) * 256 + o * 8);
            vp[0] = (f32x4){rs[q][0] * inv, rs[q][1] * inv, rs[q][2] * inv, rs[q][3] * inv}; vp[1] = (f32x4){rs[q][4] * inv, rs[q][5] * inv, rs[q][6] * inv, rs[q][7] * inv}; }
        __syncthreads();
#pragma unroll
        for (int q = 0; q < 4; ++q) { const int cc = cs + 16 * q; const int clo = cc - lo_off < 0 ? 0 : cc - lo_off, chi = cc + hi_off > GW ? GW : cc + hi_off;
            f32x4 s0 = {0.f, 0.f, 0.f, 0.f}, s1 = s0;
            for (int c2 = clo; c2 < chi; ++c2) { const LAS f32x4* vp = (const LAS f32x4*)(Vs + c2 * 256 + o * 8); s0 += vp[0]; s1 += vp[1]; }
            const float ic = 1.f / (float)(chi - clo);
            const size_t off = cbase + (size_t)(r * GW + cc) * PW; f32x4 u0, u1; unpack8(*(const u32x4*)(up + off), u0, u1);
            *(u32x4*)(pm + off) = pack8(s0 * ic - u0, s1 * ic - u1); }
        __syncthreads();
    }
}
__device__ __forceinline__ void final_rows(int gw, int lane, float* out, const float* fg, const float* rowss) {
    f32x4 g4[8];
#pragma unroll
    for (int j = 0; j < 8; ++j) g4[j] = *(const f32x4*)(fg + 256 * j + 4 * lane);
    for (int r = gw * 8; r < gw * 8 + 8; ++r) {
        const float part = lane < 32 ? rowss[(size_t)r * 32 + lane] : 0.f;
        const float rstd = rsqrtf(wave_sum(part) * (1.f / D) + EPS);
        float* rp = out + (size_t)r * D + 4 * lane;
        f32x4 v[8];
#pragma unroll
        for (int j = 0; j < 8; ++j) v[j] = *(const f32x4*)(rp + 256 * j);
#pragma unroll
        for (int j = 0; j < 8; ++j) *(f32x4*)(rp + 256 * j) = v[j] * rstd * g4[j];
    }
}

typedef pg8::Cfg<D / 64, 0, D * 2, (size_t)256 * D * 2, (size_t)128 * D * 2, 128, 0, D * 2, (size_t)256 * D * 2, (size_t)128 * D * 2, 128, 0> CfgDense2048;
typedef pg8::Cfg<512 / 64, 0, XK * 2, (size_t)256 * XK * 2, (size_t)128 * XK * 2, 128, XGS * 2, 512 * 2, 0, (size_t)128 * 512 * 2, 128, PGS * 2> CfgS;
typedef pg8::Cfg<256 / 64, 0, PW * 2, (size_t)256 * PW * 2, (size_t)128 * PW * 2, 128, 512, 256 * 2, 0, (size_t)128 * 256 * 2, 128, (size_t)65536 * 2> CfgPool;
typedef pg8::Cfg<XK / 64, 0, XK * 2, (size_t)256 * XK * 2, (size_t)128 * XK * 2, 128, XGS * 2, XK * 2, (size_t)256 * XK * 2, (size_t)128 * XK * 2, 128, MGS * 2> CfgY;
typedef pg8::Cfg<SW / 64, 1, (unsigned)(YGS * 2), (size_t)256 * 32, (size_t)128 * 32, 4 * YGS * 2, 0, SW * 2, (size_t)128 * SW * 2, (size_t)1024 * SW * 2, 128, 0> CfgGlu;

constexpr int CW_BAR = 0, CW_Q0 = 4096, CW_Q3 = 4096 + 64;
constexpr size_t CTL_ZERO_BYTES = 65536;
constexpr int MISC_OFF = 143360;

__global__ void __launch_bounds__(NTHREADS, 2) mk_fwd(Args a) {
    extern __shared__ __attribute__((aligned(16))) unsigned char lds_raw[];
    LAS unsigned char* lds = (LAS unsigned char*)lds_raw;
    volatile LAS unsigned* MISC = (volatile LAS unsigned*)(lds + MISC_OFF);
    const int G = gridDim.x, bx = blockIdx.x, tid = threadIdx.x, lane = tid & 63, wave = __builtin_amdgcn_readfirstlane(tid >> 6);
    const int vcu = (G % 8 == 0) ? (bx % 8) * (G / 8) + bx / 8 : bx;
    const int lo = a.ph_lo, hi = a.ph_hi;
    unsigned* ctl = (unsigned*)(a.ws + WS_CTL);
    if (tid < 16) MISC[tid] = 0u;
    __syncthreads();
    XcdBarrier bar = xcd_barrier_post(ctl + CW_BAR, MISC);
#define IN(k) (lo <= (k) && (k) < hi)
#define SEAM(k) do { if (IN(k) && IN((k) + 1)) xcd_barrier(bar); } while (0)
    if (IN(0)) {
        if (bx < NG) ssm_tables((LAS float*)lds, bx, a.in[10], a.in[11], a.in[12], a.in[13], a.in[14], a.in[15], a.in[16], (f16*)(a.ws + WS_PG) + (size_t)bx * PGS, (f16*)(a.ws + WS_MG) + (size_t)bx * MGS);
        else gemv_item((LAS float*)lds, bx - NG, a.in[1], a.in[3], a.in[4], a.in[5], (float*)(a.ws + WS_MOD));
        LAS float* scr = (LAS float*)lds + wave * (64 * 33);
        for (;;) { const int it = q_pop(ctl + CW_Q0, (volatile LAS int*)(MISC + 2)); if (it * 8 >= TI_ALL) break;
            transpose_dispatch(it * 8 + wave, a.in[7], a.in[20], a.in[18], a.in[8], a.ws, scr, lane); }
    }
    SEAM(0);
    if (IN(1)) norm_rows(vcu * NWAVES + wave, lane, a.in[0], a.in[2], a.in[6], (const float*)(a.ws + WS_MOD), (f16*)(a.ws + WS_H));
    SEAM(1);
    if (IN(2)) {
        pg8::DenseOrder S; S.init(M_LAT / 256, 4096 / 256, G, bx);
        EpiInProj E{(f16*)(a.ws + WS_UPOOL), (f16*)(a.ws + WS_X), (f16*)(a.ws + WS_ZS)};
        pg8::gemm_phase<CfgDense2048, EpiInProj, pg8::DenseOrder, true, true>(lds, (const char*)(a.ws + WS_H), (const char*)(a.ws + WS_WIN), S, E);
        for (int it = bx; it < 256; it += G) ctx_item((LAS float*)lds, it, (const f16*)(a.ws + WS_H) + (size_t)M_LAT * D, (const f16*)(a.ws + WS_WIN) + (size_t)PW * D, (f16*)(a.ws + WS_X));
    }
    SEAM(2);
    if (IN(3)) {
        pg8::ListOrder S; S.init(NG * 3, 3, 1, G, vcu);
        EpiS E{(float*)(a.ws + WS_S)};
        pg8::gemm_phase<CfgS, EpiS, pg8::ListOrder, true, true>(lds, (const char*)(a.ws + WS_X + 512), (const char*)(a.ws + WS_PG), S, E);
        for (;;) { const int it = q_pop(ctl + CW_Q3, (volatile LAS int*)(MISC + 2)); if (it >= 256) break; pm_item((LAS float*)lds, it, (const f16*)(a.ws + WS_UPOOL), (f16*)(a.ws + WS_PM)); }
    }
    SEAM(3);
    if (IN(4)) {
        for (int it = bx; it < 256; it += G) ssm_scan((LAS float*)lds, it, a.in[10], a.in[11], a.in[12], (const float*)(a.ws + WS_S), (f16*)(a.ws + WS_X));
        pg8::ListOrder S; S.init(4 * 64, 64, 1, G, vcu);
        EpiPool E{(f16*)(a.ws + WS_BRANCH), (const f16*)(a.ws + WS_ZS), a.in[9]};
        pg8::gemm_phase<CfgPool, EpiPool, pg8::ListOrder, true, true>(lds, (const char*)(a.ws + WS_PM), (const char*)(a.ws + WS_WPOOL), S, E);
    }
    SEAM(4);
    if (IN(5)) {
        pg8::ListOrder S; S.init(NG * 4, 2, 2, G, vcu);
        EpiY E{(f16*)(a.ws + WS_YG), (const f16*)(a.ws + WS_X), a.in[17]};
        pg8::gemm_phase<CfgY, EpiY, pg8::ListOrder, true, true>(lds, (const char*)(a.ws + WS_X), (const char*)(a.ws + WS_MG), S, E);
    }
    SEAM(5);
    if (IN(6)) {
        pg8::DenseOrder S; S.init(M_LAT / 256, SW / 128, G, bx);
        EpiGlu E{(f16*)(a.ws + WS_BRANCH), (const f16*)(a.ws + WS_ZS), a.in[19]};
        pg8::gemm_phase<CfgGlu, EpiGlu, pg8::DenseOrder, true, true>(lds, (const char*)(a.ws + WS_YG), (const char*)(a.ws + WS_WGLU), S, E);
    }
    SEAM(6);
    if (IN(7)) {
        pg8::DenseOrder S; S.init(M_LAT / 256, D / 256, G, bx);
        EpiOut E{a.in[0], a.out, (const float*)(a.ws + WS_MOD), (float*)(a.ws + WS_ROWSS)};
        pg8::gemm_phase<CfgDense2048, EpiOut, pg8::DenseOrder, true, true>(lds, (const char*)(a.ws + WS_BRANCH), (const char*)(a.ws + WS_WOUT), S, E);
    }
    SEAM(7);
    if (IN(8)) final_rows(vcu * NWAVES + wave, lane, a.out, a.in[21], (const float*)(a.ws + WS_ROWSS));
#undef IN
#undef SEAM
}

#ifndef MK_SPLIT
#define MK_SPLIT 0
#endif
extern "C" void kernel_launch(void* const* d_in, const int* in_sizes, int n_in, void* d_out, int out_size, void* d_ws, size_t ws_size, hipStream_t stream) {
    static int grid = 0;
    if (grid == 0) {
        if (ws_size < WS_END + MiB || n_in != 22) { fprintf(stderr, "kernel_launch: unexpected workspace / inputs: %zu %d\n", ws_size, n_in); grid = -1; return; }
        if (hipFuncSetAttribute((const void*)mk_fwd, hipFuncAttributeMaxDynamicSharedMemorySize, LDS_BYTES) != hipSuccess) { fprintf(stderr, "hipFuncSetAttribute failed\n"); grid = -1; return; }
        int dev = 0, cus = 0, per_cu = 0;
        if (hipGetDevice(&dev) != hipSuccess || hipDeviceGetAttribute(&cus, hipDeviceAttributeMultiprocessorCount, dev) != hipSuccess) { grid = -1; return; }
        if (hipOccupancyMaxActiveBlocksPerMultiprocessor(&per_cu, (const void*)mk_fwd, NTHREADS, LDS_BYTES) != hipSuccess || per_cu < 1) { fprintf(stderr, "occupancy query: %d\n", per_cu); (void)hipGetLastError(); }
        grid = cus;
    }
    if (grid < 0) return;
    if (hipMemsetAsync((char*)d_ws + WS_CTL, 0, CTL_ZERO_BYTES, stream) != hipSuccess) return;
    Args a{}; for (int i = 0; i < 22; ++i) a.in[i] = (const float*)d_in[i]; a.out = (float*)d_out; a.ws = (unsigned char*)d_ws;
#if MK_SPLIT
    for (int ph = 0; ph < 9; ++ph) { a.ph_lo = ph; a.ph_hi = ph + 1; hipLaunchKernelGGL(mk_fwd, dim3(grid), dim3(NTHREADS), LDS_BYTES, stream, a); }
#else
    a.ph_lo = 0; a.ph_hi = 9; hipLaunchKernelGGL(mk_fwd, dim3(grid), dim3(NTHREADS), LDS_BYTES, stream, a);
#endif
}
```

```cpp
#include <hip/hip_runtime.h>
#include <cstdint>
#include <cstdio>
#ifndef PROBE_PH
#define PROBE_PH (-1)
#endif
#ifndef PROBE_SUB
#define PROBE_SUB (-1)
#endif
#define PROBE_MULT 8
#ifndef PROBE_BX
#define PROBE_BX 0
#endif
#ifndef REPEAT_PH
#define REPEAT_PH (-1)
#endif

#define LAS __attribute__((address_space(3)))
#ifndef OP_BF16
#define OP_BF16 1
#endif
#if OP_BF16
typedef __bf16 f16;
typedef __bf16 f16x8 __attribute__((ext_vector_type(8)));
typedef __bf16 f16x2 __attribute__((ext_vector_type(2)));
#define MFMA16(a, b, c) __builtin_amdgcn_mfma_f32_16x16x32_bf16(a, b, c, 0, 0, 0)
#define MFMA32(a, b, c) __builtin_amdgcn_mfma_f32_32x32x16_bf16(a, b, c, 0, 0, 0)
#else
typedef _Float16 f16;
typedef _Float16 f16x8 __attribute__((ext_vector_type(8)));
typedef _Float16 f16x2 __attribute__((ext_vector_type(2)));
#define MFMA16(a, b, c) __builtin_amdgcn_mfma_f32_16x16x32_f16(a, b, c, 0, 0, 0)
#define MFMA32(a, b, c) __builtin_amdgcn_mfma_f32_32x32x16_f16(a, b, c, 0, 0, 0)
#endif
typedef float f32x4 __attribute__((ext_vector_type(4)));
typedef float f32x2 __attribute__((ext_vector_type(2)));
typedef unsigned u32x4 __attribute__((ext_vector_type(4)));
typedef unsigned u32x2 __attribute__((ext_vector_type(2)));

__device__ __forceinline__ unsigned pk_f16(float lo, float hi) { f16x2 v; v.x = (f16)lo; v.y = (f16)hi; return __builtin_bit_cast(unsigned, v); }
__device__ __forceinline__ float f16lo(unsigned w) { f16x2 v = __builtin_bit_cast(f16x2, w); return (float)v.x; }
__device__ __forceinline__ float f16hi(unsigned w) { f16x2 v = __builtin_bit_cast(f16x2, w); return (float)v.y; }
typedef _Float16 h16x2 __attribute__((ext_vector_type(2)));
__device__ __forceinline__ unsigned pk_h16(float lo, float hi) { h16x2 v; v.x = (_Float16)lo; v.y = (_Float16)hi; return __builtin_bit_cast(unsigned, v); }
__device__ __forceinline__ float h16lo(unsigned w) { h16x2 v = __builtin_bit_cast(h16x2, w); return (float)v.x; }
__device__ __forceinline__ float h16hi(unsigned w) { h16x2 v = __builtin_bit_cast(h16x2, w); return (float)v.y; }
__device__ __forceinline__ f32x4 ld_nt(const float* p) { return __builtin_nontemporal_load((const f32x4*)p); }
__device__ __forceinline__ float fast_sigmoid(float v) { return __builtin_amdgcn_rcpf(1.f + __expf(-v)); }
__device__ __forceinline__ float silu_f(float v) { return v * fast_sigmoid(v); }
__device__ __forceinline__ float gelu_tanh_f(float y) { const float t = 0.7978845608028654f * (y + 0.044715f * y * y * y); return y * fast_sigmoid(2.f * t); }

constexpr int D = 2048, BATCH = 2, SEQ = 8192, CTX = 256, GW = 64, ROWS = SEQ / GW;
constexpr int M_LAT = BATCH * SEQ, M_CTX = BATCH * CTX, M_ALL = M_LAT + M_CTX;
constexpr int PW = 1024, SW = 1024, NG = 64, NS = 64, GH = 16;
constexpr int TC = 32;
constexpr int NLC = M_LAT / TC;
constexpr int NCC = M_CTX / TC;
constexpr int NCH = NLC + NCC;
constexpr int XK = 256 + TC * GH;
constexpr float EPS = 1e-6f;
constexpr int NWAVES = 8, NTHREADS = 512;

constexpr size_t MiB = 1u << 20;
constexpr size_t WS_CTL = 0;
constexpr size_t WS_MOD = 1 * MiB;
constexpr size_t WS_ROWSS = 2 * MiB;
constexpr size_t WS_WIN = 4 * MiB;
constexpr size_t WS_WOUT = 20 * MiB;
constexpr size_t WS_WGLU = 28 * MiB;
constexpr size_t WS_WPOOL = 32 * MiB;
constexpr size_t WS_PG = 33 * MiB;
constexpr size_t WS_QG = 49 * MiB;
constexpr size_t WS_KTH = 65 * MiB;
constexpr size_t WS_H = 97 * MiB;
constexpr size_t WS_BRANCH = WS_H;
constexpr size_t WS_XO = 163 * MiB;
constexpr size_t WS_UPOOL = 163 * MiB;
constexpr size_t WS_X = 195 * MiB;
constexpr size_t WS_ZS = 246 * MiB;
constexpr size_t WS_PM = 310 * MiB;
constexpr size_t WS_S = 342 * MiB;
constexpr size_t WS_YG = 376 * MiB;
constexpr size_t WS_YF = 408 * MiB;
constexpr size_t WS_END = 472 * MiB;
constexpr size_t XGS = (size_t)NCH * XK;
constexpr size_t YGS = (size_t)M_LAT * GH;
constexpr size_t QGS = (size_t)512 * 256;
constexpr size_t PGS = (size_t)256 * 512;

namespace pg8 {
constexpr int BM = 256, BK = 64, HALF = 128, HTB = HALF * BK * 2, STAGE_BYTES = 8 * HTB, NXCD = 8, WGM = 8;
__host__ __device__ __forceinline__ int lds_byte(int r, int c) { const int st = (r >> 4) * 2 + (c >> 5), rr = r & 15, cc = c & 31, ob = rr * 64 + cc * 2; return st * 1024 + (ob ^ (((ob >> 9) & 1) << 5)); }
__host__ __device__ __forceinline__ void stage_rc(int b, int& R, int& C) { const int st = b / 1024, sb = b % 1024, swz = sb ^ (((sb >> 9) & 1) << 5); R = (st >> 1) * 16 + swz / 64; C = (st & 1) * 32 + (swz % 64) / 2; }
__host__ __device__ __forceinline__ int perm32(int rho) { const int n = rho >> 4, i = rho & 15; return 8 * (i >> 2) + 4 * n + (i & 3); }

struct Unit { int pm, pn, g; };
template <int NT_, int AMODE_, unsigned A_ROW_, size_t A_T_, size_t A_H_, size_t A_K_, size_t A_G_, unsigned B_ROW_, size_t B_T_, size_t B_H_, size_t B_K_, size_t B_G_, int BMODE_ = 0>
struct Cfg { static constexpr int NT = NT_, AMODE = AMODE_, BMODE = BMODE_; static constexpr unsigned A_ROW = A_ROW_, B_ROW = B_ROW_; static constexpr size_t A_T = A_T_, A_H = A_H_, A_K = A_K_, A_G = A_G_, B_T = B_T_, B_H = B_H_, B_K = B_K_, B_G = B_G_; };
constexpr size_t KTG = 63 * 512;

struct DenseOrder {
    int nM, nN, nwg, G, c;
    __device__ void init(int nM_, int nN_, int G_, int c_) { nM = nM_; nN = nN_; nwg = nM * nN; G = G_; c = c_; }
    __device__ bool next(int i, Unit& u) const {
        const long L = (long)i * G + c; if (L >= nwg) return false;
        int wgid = (int)L; { const int q = nwg / NXCD, r = nwg % NXCD, xcd = wgid % NXCD, off = wgid / NXCD; wgid = (xcd < r ? xcd * (q + 1) : r * (q + 1) + (xcd - r) * q) + off; }
        const int nig = WGM * nN, gid = wgid / nig, fm = gid * WGM, gsz = (nM - fm) < WGM ? (nM - fm) : WGM;
        u.pm = fm + ((wgid % nig) % gsz); u.pn = (wgid % nig) / gsz; u.g = 0; return true;
    }
};
struct ListOrder {
    int n, npm, npn, G, vc;
    __device__ void init(int n_, int npm_, int npn_, int G_, int vc_) { n = n_; npm = npm_; npn = npn_; G = G_; vc = vc_; }
    __device__ bool next(int i, Unit& u) const { const int L = i * G + vc; if (L >= n) return false; u.g = L / (npm * npn); u.pm = (L / npn) % npm; u.pn = L % npn; return true; }
};

struct OneUnit { Unit u; bool have;
    __device__ bool next(int i, Unit& o) const { if (i != 0 || !have) return false; o = u; return true; } };

template <class CF, class Epi, class Sched, bool ALIGN_EPI, bool SP2>
__device__ __forceinline__ void gemm_phase(LAS unsigned char* lds, const char* gA, const char* gB, const Sched& S, const Epi& E, const char* gB2 = nullptr) {
    constexpr int AMODE = CF::AMODE, BMODE = CF::BMODE;
    static_assert(SP2, "only the two-super-phase loop is kept");
    const int tid = threadIdx.x, wid = __builtin_amdgcn_readfirstlane(tid >> 6), lane = tid & 63, wr = wid >> 2, wc = wid & 3, fr = lane & 15, fq = lane >> 4;
    constexpr int nt = CF::NT;
    unsigned voffA, voffB, voffT = 0;
    { int R, C; stage_rc(tid * 16, R, C); const int Rb = Epi::PERM ? ((R & ~31) + perm32(R & 31)) : R;
      voffA = AMODE == 0 ? (unsigned)R * CF::A_ROW + (unsigned)C * 2u : (unsigned)(C >> 4) * CF::A_ROW + (unsigned)R * 32u + (unsigned)(C & 15) * 2u;
      voffB = (unsigned)Rb * CF::B_ROW + (unsigned)C * 2u;
      if constexpr (BMODE == 1) voffT = (unsigned)Rb * 32u + 1536u - (unsigned)(C >> 4) * 512u + (unsigned)(C & 15) * 2u; }
    constexpr size_t a64 = AMODE == 0 ? (size_t)64 * CF::A_ROW : (size_t)64 * 32, b64 = (size_t)64 * CF::B_ROW, t64 = (size_t)64 * 32;
    constexpr size_t akstep = CF::A_K, bkstep = CF::B_K, ahstep = CF::A_H, bhstep = CF::B_H;
    const unsigned ldsw = (unsigned)wid * 1024u;
    const int aoff = lds_byte(wr * 64 + fr, fq * 8), boff = lds_byte(wc * 32 + fr, fq * 8);
#define PG8_SA(b, h) (((b) * 2 + (h)) * HTB)
#define PG8_SB(b, h) ((4 + (b) * 2 + (h)) * HTB)
#define PG8_STAGE(bufoff, gbase, voff, step64) do { \
        __builtin_amdgcn_global_load_lds((const unsigned*)((const char*)(gbase) + (voff)), (LAS unsigned*)(lds + (bufoff) + ldsw), 16, 0, 0); \
        __builtin_amdgcn_global_load_lds((const unsigned*)((const char*)(gbase) + (step64) + (voff)), (LAS unsigned*)(lds + (bufoff) + ldsw + 8192), 16, 0, 0); } while (0)
#define PG8_STAGE_A(bufoff, gbase) PG8_STAGE(bufoff, gbase, voffA, a64)
#define PG8_STAGE_B(bufoff, bp, hb, tz) do { if (BMODE == 1 && (tz)) PG8_STAGE(bufoff, (bp) + (hb) * 4096, voffT, t64); else PG8_STAGE(bufoff, (bp) + (hb) * bhstep, voffB, b64); } while (0)
#define PG8_LDA(dst, b, h) do { _Pragma("unroll") for (int m = 0; m < 4; ++m) _Pragma("unroll") for (int k = 0; k < 2; ++k) dst[m][k] = *(const LAS f16x8*)(lds + PG8_SA(b, h) + aoff + m * 2048 + k * 1024); } while (0)
#define PG8_LDB(dst, b, h) do { _Pragma("unroll") for (int n = 0; n < 2; ++n) _Pragma("unroll") for (int k = 0; k < 2; ++k) dst[n][k] = *(const LAS f16x8*)(lds + PG8_SB(b, h) + boff + n * 2048 + k * 1024); } while (0)
#define PG8_MMA(ai, bj, At, Bt) do { __builtin_amdgcn_s_setprio(1); _Pragma("unroll") for (int m = 0; m < 4; ++m) _Pragma("unroll") for (int n = 0; n < 2; ++n) _Pragma("unroll") for (int k = 0; k < 2; ++k) \
        acc[ai][bj][m][n] = MFMA16(Bt[n][k], At[m][k], acc[ai][bj][m][n]); __builtin_amdgcn_s_setprio(0); } while (0)
#define PG8_WAIT_V(n) asm volatile("s_waitcnt vmcnt(" #n ")" ::: "memory")
#define PG8_WAIT_L(n) asm volatile("s_waitcnt lgkmcnt(" #n ")" ::: "memory")
#define PG8_BAR __builtin_amdgcn_s_barrier()
#define PG8_SCHED __builtin_amdgcn_sched_barrier(0)
    Unit cur, nxt; int ui = 0;
    if (!S.next(0, cur)) return;
    f32x4 acc[2][2][4][2];
#pragma unroll
    for (int a = 0; a < 2; ++a)
#pragma unroll
        for (int b = 0; b < 2; ++b)
#pragma unroll
            for (int m = 0; m < 4; ++m)
#pragma unroll
                for (int n = 0; n < 2; ++n) acc[a][b][m][n] = (f32x4){0.f, 0.f, 0.f, 0.f};
    f16x8 At[4][2], B0[2][2], B1[2][2];
    const char* cA = gA + (size_t)cur.g * CF::A_G + (size_t)cur.pm * CF::A_T; const char* cB = gB + (size_t)cur.g * CF::B_G + (size_t)cur.pn * CF::B_T;
    const char* cT = BMODE == 1 ? gB2 + (size_t)cur.g * KTG + (size_t)cur.pn * 8192 + 14336 : nullptr;
    PG8_STAGE_B(PG8_SB(0, 0), cB, 0, false); PG8_STAGE_B(PG8_SB(0, 1), cB, 1, false); PG8_STAGE_A(PG8_SA(0, 0), cA); PG8_STAGE_A(PG8_SA(0, 1), cA + ahstep);
    if (wr == 1) PG8_BAR;
    PG8_WAIT_V(2); PG8_BAR;
    PG8_STAGE_B(PG8_SB(1, 0), cB + bkstep, 0, false); PG8_STAGE_A(PG8_SA(1, 0), cA + akstep); PG8_STAGE_B(PG8_SB(1, 1), cB + bkstep, 1, false);
    PG8_WAIT_V(6); PG8_BAR;
    for (;;) {
        const bool has_next = S.next(ui + 1, nxt);
        const char* nA = has_next ? gA + (size_t)nxt.g * CF::A_G + (size_t)nxt.pm * CF::A_T : cA; const char* nB = has_next ? gB + (size_t)nxt.g * CF::B_G + (size_t)nxt.pn * CF::B_T : cB;
        for (int t = 0; t < nt; t += 2) {
            const bool last = (t == nt - 2);
            const bool tz = BMODE == 1 && !last && (t + 2 >= 4);
            const char* a1 = cA + (size_t)(t + 1) * akstep;
            const char* a2 = last ? nA : cA + (size_t)(t + 2) * akstep;
            const char* b2 = last ? nB : (tz ? cT - (size_t)(t - 2) * 2048 : cB + (size_t)(t + 2) * bkstep);
            const char* a3 = a2 + akstep; const char* b3 = tz ? b2 - 2048 : b2 + bkstep;
            PG8_LDB(B0, 0, 0); PG8_LDB(B1, 0, 1); PG8_SCHED; PG8_LDA(At, 0, 0); PG8_STAGE_A(PG8_SA(1, 1), a1 + ahstep);
            PG8_WAIT_V(8); PG8_WAIT_L(0); PG8_BAR; PG8_MMA(0, 0, At, B0); PG8_MMA(0, 1, At, B1); PG8_BAR; PG8_SCHED;
            PG8_LDA(At, 0, 1); PG8_STAGE_B(PG8_SB(0, 0), b2, 0, tz); PG8_STAGE_B(PG8_SB(0, 1), b2, 1, tz); PG8_STAGE_A(PG8_SA(0, 0), a2);
            PG8_WAIT_V(8); PG8_WAIT_L(0); PG8_BAR; PG8_MMA(1, 0, At, B0); PG8_MMA(1, 1, At, B1); PG8_BAR; PG8_SCHED;
            PG8_LDB(B0, 1, 0); PG8_LDB(B1, 1, 1); PG8_SCHED; PG8_LDA(At, 1, 0); PG8_STAGE_A(PG8_SA(0, 1), a2 + ahstep);
            PG8_WAIT_V(8); PG8_WAIT_L(0); PG8_BAR; PG8_MMA(0, 0, At, B0); PG8_MMA(0, 1, At, B1); PG8_BAR; PG8_SCHED;
            PG8_LDA(At, 1, 1); PG8_STAGE_B(PG8_SB(1, 0), b3, 0, tz); PG8_STAGE_B(PG8_SB(1, 1), b3, 1, tz); PG8_STAGE_A(PG8_SA(1, 0), a3);
            PG8_WAIT_V(8); PG8_WAIT_L(0); PG8_BAR; PG8_MMA(1, 0, At, B0); PG8_MMA(1, 1, At, B1); PG8_BAR; PG8_SCHED;
        }
        if constexpr (ALIGN_EPI) { if (wr == 0) PG8_BAR; }
        E(acc, cur, wr, wc, fr, fq);
        if (!has_next) break;
#pragma unroll
        for (int a = 0; a < 2; ++a)
#pragma unroll
            for (int b = 0; b < 2; ++b)
#pragma unroll
                for (int m = 0; m < 4; ++m)
#pragma unroll
                    for (int n = 0; n < 2; ++n) acc[a][b][m][n] = (f32x4){0.f, 0.f, 0.f, 0.f};
        cur = nxt; cA = nA; cB = nB; ++ui;
        if constexpr (BMODE == 1) cT = gB2 + (size_t)cur.g * KTG + (size_t)cur.pn * 8192 + 14336;
        if constexpr (ALIGN_EPI) { if (wr == 1) PG8_BAR; }
    }
    PG8_WAIT_V(0);
    if constexpr (!ALIGN_EPI) { if (wr == 0) PG8_BAR; }
    PG8_BAR;
#undef PG8_SA
#undef PG8_SB
#undef PG8_STAGE
#undef PG8_STAGE_A
#undef PG8_STAGE_B
#undef PG8_LDA
#undef PG8_LDB
#undef PG8_MMA
#undef PG8_WAIT_V
#undef PG8_WAIT_L
#undef PG8_BAR
#undef PG8_SCHED
}
}
using pg8::Unit;
using pg8::HALF;
typedef const f32x4 (&AccRef)[2][2][4][2];

__device__ __forceinline__ u32x4 pack8(const f32x4 v0, const f32x4 v1) { u32x4 w; w.x = pk_f16(v0[0], v0[1]); w.y = pk_f16(v0[2], v0[3]); w.z = pk_f16(v1[0], v1[1]); w.w = pk_f16(v1[2], v1[3]); return w; }
__device__ __forceinline__ u32x4 pack8h(const f32x4 v0, const f32x4 v1) { u32x4 w; w.x = pk_h16(v0[0], v0[1]); w.y = pk_h16(v0[2], v0[3]); w.z = pk_h16(v1[0], v1[1]); w.w = pk_h16(v1[2], v1[3]); return w; }
__device__ __forceinline__ void unpack8h(const u32x4 w, f32x4& v0, f32x4& v1) { v0 = (f32x4){h16lo(w.x), h16hi(w.x), h16lo(w.y), h16hi(w.y)}; v1 = (f32x4){h16lo(w.z), h16hi(w.z), h16lo(w.w), h16hi(w.w)}; }
__device__ __forceinline__ void unpack8(const u32x4 w, f32x4& v0, f32x4& v1) { v0 = (f32x4){f16lo(w.x), f16hi(w.x), f16lo(w.y), f16hi(w.y)}; v1 = (f32x4){f16lo(w.z), f16hi(w.z), f16lo(w.w), f16hi(w.w)}; }

struct EpiInProj {
    static constexpr bool PERM = true;
    f16* upool; f16* X; f16* zs;
    __device__ __forceinline__ void operator()(AccRef acc, const Unit& u, int wr, int wc, int fr, int fq) const {
        int row0 = u.pm * 256 + wr * 64 + fr; asm volatile("" : "+v"(row0)); int col0 = u.pn * 256 + wc * 32 + 8 * fq; asm volatile("" : "+v"(col0));
#pragma unroll
        for (int ai = 0; ai < 2; ++ai)
#pragma unroll
            for (int m = 0; m < 4; ++m) { const int row = row0 + ai * HALF + m * 16;
#pragma unroll
                for (int bj = 0; bj < 2; ++bj) { const int col = col0 + bj * HALF; f32x4 v0 = acc[ai][bj][m][0], v1 = acc[ai][bj][m][1];
                    if (u.pn < 4) { *(u32x4*)(upool + (size_t)row * PW + col) = pack8(v0, v1); }
                    else if (u.pn < 8) { const int cs = col - PW, gg = cs >> 4, hh = cs & 15, lc = row >> 5, s = row & 31;
                        *(u32x4*)(X + (size_t)gg * XGS + (size_t)lc * XK + 256 + s * 16 + hh) = pack8(v0, v1); }
                    else {
#pragma unroll
                        for (int j = 0; j < 4; ++j) { v0[j] = silu_f(v0[j]); v1[j] = silu_f(v1[j]); }
                        *(u32x4*)(zs + (size_t)row * D + (col - PW - SW)) = pack8(v0, v1); } } }
    }
};
struct EpiCtx {
    static constexpr bool PERM = true;
    f16* X;
    __device__ __forceinline__ void operator()(AccRef acc, const Unit& u, int wr, int wc, int fr, int fq) const {
        int row0 = u.pm * 256 + wr * 64 + fr; asm volatile("" : "+v"(row0)); int col0 = u.pn * 256 + wc * 32 + 8 * fq; asm volatile("" : "+v"(col0));
#pragma unroll
        for (int ai = 0; ai < 2; ++ai)
#pragma unroll
            for (int m = 0; m < 4; ++m) { const int row = row0 + ai * HALF + m * 16;
#pragma unroll
                for (int bj = 0; bj < 2; ++bj) { const int cs = col0 + bj * HALF, gg = cs >> 4, hh = cs & 15, lc = NLC + (row >> 5), s = row & 31;
                    *(u32x4*)(X + (size_t)gg * XGS + (size_t)lc * XK + 256 + s * 16 + hh) = pack8(acc[ai][bj][m][0], acc[ai][bj][m][1]); } }
    }
};
struct EpiPool {
    static constexpr bool PERM = true;
    f16* branch; const f16* zs; const float* pscale;
    __device__ __forceinline__ void operator()(AccRef acc, const Unit& u, int wr, int wc, int fr, int fq) const {
        int row0 = u.pm * 256 + wr * 64 + fr; asm volatile("" : "+v"(row0)); int col0 = u.g * 256 + wc * 32 + 8 * fq; asm volatile("" : "+v"(col0));
        f32x4 sc[2][2];
#pragma unroll
        for (int bj = 0; bj < 2; ++bj) { sc[bj][0] = *(const f32x4*)(pscale + col0 + bj * HALF); sc[bj][1] = *(const f32x4*)(pscale + col0 + bj * HALF + 4); }
#pragma unroll
        for (int ai = 0; ai < 2; ++ai)
#pragma unroll
          for (int mp = 0; mp < 2; ++mp) { u32x4 zv[2][2];
#pragma unroll
            for (int mm = 0; mm < 2; ++mm)
#pragma unroll
                for (int bj = 0; bj < 2; ++bj) zv[mm][bj] = *(const u32x4*)(zs + (size_t)(row0 + ai * HALF + (mp * 2 + mm) * 16) * D + col0 + bj * HALF);
            __builtin_amdgcn_sched_barrier(0);
#pragma unroll
            for (int mm = 0; mm < 2; ++mm)
#pragma unroll
                for (int bj = 0; bj < 2; ++bj) { const int m = mp * 2 + mm; const size_t o = (size_t)(row0 + ai * HALF + m * 16) * D + col0 + bj * HALF; f32x4 z0, z1; unpack8(zv[mm][bj], z0, z1);
                    *(u32x4*)(branch + o) = pack8(acc[ai][bj][m][0] * sc[bj][0] * z0, acc[ai][bj][m][1] * sc[bj][1] * z1); } }
    }
};
struct EpiS {
    static constexpr bool PERM = false;
    float* S;
    __device__ __forceinline__ void operator()(AccRef acc, const Unit& u, int wr, int wc, int fr, int fq) const {
        int row0 = u.pm * 256 + wr * 64 + fr; asm volatile("" : "+v"(row0)); int col0 = wc * 32 + 4 * fq; asm volatile("" : "+v"(col0));
#pragma unroll
        for (int ai = 0; ai < 2; ++ai)
#pragma unroll
            for (int m = 0; m < 4; ++m) { const int row = row0 + ai * HALF + m * 16;
                if (row < NCH) { float* rp = S + ((size_t)u.g * NCH + row) * 256 + col0;
#pragma unroll
                    for (int bj = 0; bj < 2; ++bj)
#pragma unroll
                        for (int n = 0; n < 2; ++n) *(f32x4*)(rp + bj * HALF + n * 16) = acc[ai][bj][m][n]; } }
    }
};
struct EpiY {
    static constexpr bool PERM = true;
    f16* YG; const f16* X; const float* dskip;
    __device__ __forceinline__ void operator()(AccRef acc, const Unit& u, int wr, int wc, int fr, int fq) const {
        int row0 = u.pm * 256 + wr * 64 + fr; asm volatile("" : "+v"(row0)); int col0 = u.pn * 256 + wc * 32 + 8 * fq; asm volatile("" : "+v"(col0));
        const float* dp = dskip + u.g * GH + (col0 & 15);
        const f32x4 d0 = *(const f32x4*)dp, d1 = *(const f32x4*)(dp + 4);
        const f16* Xg = X + (size_t)u.g * XGS + 256 + col0; f16* Yg = YG + (size_t)u.g * YGS + col0;
#pragma unroll
        for (int ai = 0; ai < 2; ++ai) { u32x4 uv[4][2];
#pragma unroll
            for (int m = 0; m < 4; ++m)
#pragma unroll
                for (int bj = 0; bj < 2; ++bj) uv[m][bj] = *(const u32x4*)(Xg + (size_t)(row0 + ai * HALF + m * 16) * XK + bj * HALF);
            __builtin_amdgcn_sched_barrier(0);
#pragma unroll
            for (int m = 0; m < 4; ++m)
#pragma unroll
                for (int bj = 0; bj < 2; ++bj) { f32x4 u0, u1; unpack8(uv[m][bj], u0, u1);
                    f32x4 v0 = acc[ai][bj][m][0] + d0 * u0, v1 = acc[ai][bj][m][1] + d1 * u1;
#pragma unroll
                    for (int j = 0; j < 4; ++j) { v0[j] = gelu_tanh_f(v0[j]); v1[j] = gelu_tanh_f(v1[j]); }
                    *(u32x4*)(Yg + (size_t)(row0 + ai * HALF + m * 16) * 512 + bj * HALF) = pack8(v0, v1); } }
    }
};
struct EpiGlu {
    static constexpr bool PERM = true;
    f16* branch; const f16* zs; const float* gb;
    __device__ __forceinline__ void operator()(AccRef acc, const Unit& u, int wr, int wc, int fr, int fq) const {
        int row0 = u.pm * 256 + wr * 64 + fr; asm volatile("" : "+v"(row0)); int col0 = u.pn * 128 + wc * 32 + 8 * fq; asm volatile("" : "+v"(col0));
        const f32x4 b10 = *(const f32x4*)(gb + col0), b11 = *(const f32x4*)(gb + col0 + 4), b20 = *(const f32x4*)(gb + SW + col0), b21 = *(const f32x4*)(gb + SW + col0 + 4);
        u32x4 zv[2][4];
#pragma unroll
        for (int ai = 0; ai < 2; ++ai)
#pragma unroll
            for (int m = 0; m < 4; ++m) zv[ai][m] = *(const u32x4*)(zs + (size_t)(row0 + ai * HALF + m * 16) * D + PW + col0);
        __builtin_amdgcn_sched_barrier(0);
#pragma unroll
        for (int ai = 0; ai < 2; ++ai)
#pragma unroll
            for (int m = 0; m < 4; ++m) { const size_t o = (size_t)(row0 + ai * HALF + m * 16) * D + PW + col0;
                f32x4 z0, z1; unpack8(zv[ai][m], z0, z1);
                f32x4 y10 = acc[ai][0][m][0] + b10, y11 = acc[ai][0][m][1] + b11, y20 = acc[ai][1][m][0] + b20, y21 = acc[ai][1][m][1] + b21;
#pragma unroll
                for (int j = 0; j < 4; ++j) { y10[j] = y10[j] * fast_sigmoid(y20[j]) * z0[j]; y11[j] = y11[j] * fast_sigmoid(y21[j]) * z1[j]; }
                *(u32x4*)(branch + o) = pack8(y10, y11); }
    }
};
struct EpiOut {
    static constexpr bool PERM = true;
    const float* x; f16* xo; const float* mod; float* rowss;
    __device__ __forceinline__ void operator()(AccRef acc, const Unit& u, int wr, int wc, int fr, int fq) const {
        int row0 = u.pm * 256 + wr * 64 + fr; asm volatile("" : "+v"(row0)); int col0 = u.pn * 256 + wc * 32 + 8 * fq; asm volatile("" : "+v"(col0));
        const float* gate = mod + (size_t)(u.pm >= 32 ? 1 : 0) * 3 * D + 2 * D + col0;
        f32x4 gv[2][2];
#pragma unroll
        for (int bj = 0; bj < 2; ++bj)
#pragma unroll
            for (int n = 0; n < 2; ++n) gv[bj][n] = *(const f32x4*)(gate + bj * HALF + n * 4);
#pragma unroll
        for (int ai = 0; ai < 2; ++ai)
#pragma unroll
            for (int mp = 0; mp < 2; ++mp) { f32x4 xv[2][2][2];
#pragma unroll
                for (int mm = 0; mm < 2; ++mm)
#pragma unroll
                    for (int bj = 0; bj < 2; ++bj)
#pragma unroll
                        for (int n = 0; n < 2; ++n) xv[mm][bj][n] = ld_nt(x + (size_t)(row0 + ai * HALF + (mp * 2 + mm) * 16) * D + col0 + bj * HALF + n * 4);
                __builtin_amdgcn_sched_barrier(0);
#pragma unroll
                for (int mm = 0; mm < 2; ++mm) { const int m = mp * 2 + mm; const int row = row0 + ai * HALF + m * 16; const size_t o = (size_t)row * D + col0; float ss = 0.f;
#pragma unroll
                    for (int bj = 0; bj < 2; ++bj) { const f32x4 r0 = xv[mm][bj][0] + gv[bj][0] * acc[ai][bj][m][0], r1 = xv[mm][bj][1] + gv[bj][1] * acc[ai][bj][m][1];
                        *(u32x4*)(xo + o + bj * HALF) = pack8h(r0, r1);
                        ss += ((r0[0] * r0[0] + r0[1] * r0[1]) + (r0[2] * r0[2] + r0[3] * r0[3])) + ((r1[0] * r1[0] + r1[1] * r1[1]) + (r1[2] * r1[2] + r1[3] * r1[3])); }
                    ss += __shfl_xor(ss, 16); ss += __shfl_xor(ss, 32);
                    if (fq == 0) rowss[(size_t)row * 32 + u.pn * 4 + wc] = ss; } }
    }
};

constexpr int LDS_BYTES = 147456;

struct Args { const float* in[22]; float* out; unsigned char* ws; int ph_lo, ph_hi; };

constexpr int APS = 132;
constexpr int T_AP = 0, T_QQ = T_AP + 33 * APS, T_BR = T_QQ + 256, T_BI = T_BR + 2048, T_CR = T_BI + 2048, T_CI = T_CR + 2048, T_END = T_CI + 2048;
static_assert(T_END * 4 <= 131072 && (T_BR % 4) == 0 && (T_QQ % 4) == 0, "tables LDS");
__device__ __forceinline__ void ssm_tables(LAS float* L, int item, const float* lam_re, const float* lam_im, const float* log_dt, const float* b_re, const float* b_im,
                                           const float* c_re, const float* c_im, f16* PG, f16* QG, f16* KTH) {
    const int g = item >> 1, dir = item & 1;
    const int tid = threadIdx.x, lane = tid & 63, wave = tid >> 6;
    f16* PGg = PG + (size_t)g * PGS; f16* QGg = QG + (size_t)g * QGS; f16* KTg = KTH + (size_t)g * (63 * 256);
    float cre[4], cim[4], bre[4], bim[4];
#pragma unroll
    for (int q = 0; q < 4; ++q) { const int i = tid + NTHREADS * q; const int d2 = i / 1024, r = i % 1024; const int pg = d2 * NG + g;
        cre[q] = c_re[(size_t)pg * 1024 + r]; cim[q] = c_im[(size_t)pg * 1024 + r]; bre[q] = b_re[(size_t)pg * 1024 + r]; bim[q] = b_im[(size_t)pg * 1024 + r]; }
    { const int n = tid >> 3, seg = tid & 7; const int pg = dir * NG + g;
      const float dt = expf(log_dt[pg]), lr = lam_re[pg * NS + n], li = lam_im[pg * NS + n];
      const float th = li * dt; float sn, cs; sincosf(th, &sn, &cs);
      const float er = expf(lr * dt); const float ar = er * cs, ai = er * sn;
      float pr, pi; { const float eb = expf((float)(4 * seg) * lr * dt); float s4, c4; sincosf((float)(4 * seg) * th, &s4, &c4); pr = eb * c4; pi = eb * s4; }
#pragma unroll
      for (int j = 0; j < 4; ++j) { *(LAS f32x2*)(L + T_AP + (4 * seg + j) * APS + 2 * n) = (f32x2){pr, pi}; const float nr = pr * ar - pi * ai, ni = pr * ai + pi * ar; pr = nr; pi = ni; }
      if (seg == 7) *(LAS f32x2*)(L + T_AP + 32 * APS + 2 * n) = (f32x2){pr, pi}; }
    if (tid < 128) { const int d2 = tid >> 6, n = tid & 63; const int pg = d2 * NG + g;
      const float dt = expf(log_dt[pg]), lr = lam_re[pg * NS + n], li = lam_im[pg * NS + n];
      const float th = li * dt; float sn, cs; sincosf(th, &sn, &cs); const float sh = sinf(0.5f * th);
      const float em1 = expm1f(lr * dt), er = em1 + 1.f;
      const float nr = em1 * cs - 2.f * sh * sh, ni = er * sn, den = lr * lr + li * li;
      *(LAS f32x2*)(L + T_QQ + (d2 * 64 + n) * 2) = (f32x2){(nr * lr + ni * li) / den, (ni * lr - nr * li) / den}; }
#pragma unroll
    for (int q = 0; q < 4; ++q) { const int i = tid + NTHREADS * q; L[T_CR + i] = cre[q]; L[T_CI + i] = cim[q]; }
    __syncthreads();
#pragma unroll
    for (int q = 0; q < 4; ++q) { const int i = tid + NTHREADS * q; const int d2 = i / 1024, n = (i / 16) % 64;
        const f32x2 qq = *(const LAS f32x2*)(L + T_QQ + (d2 * 64 + n) * 2);
        L[T_BR + i] = qq.x * bre[q] - qq.y * bim[q]; L[T_BI + i] = qq.x * bim[q] + qq.y * bre[q]; }
    __syncthreads();
    { const int fr = lane & 15, fq = lane >> 4;
      auto bfrag = [&](int d2, int kk) { f16x8 v;
#pragma unroll
          for (int e2 = 0; e2 < 4; ++e2) { const int n = 16 * kk + 4 * fq + e2; v[2 * e2] = (f16)L[T_BR + d2 * 1024 + n * 16 + fr]; v[2 * e2 + 1] = (f16)L[T_BI + d2 * 1024 + n * 16 + fr]; }
          return v; };
      auto afrag = [&](int d2, int kk, int j, bool unit) { f16x8 v;
#pragma unroll
          for (int e2 = 0; e2 < 4; ++e2) { const int n = 16 * kk + 4 * fq + e2; const float cr = L[T_CR + d2 * 1024 + fr * 64 + n], ci = L[T_CI + d2 * 1024 + fr * 64 + n];
              f32x2 p = {1.f, 0.f}; if (!unit) p = *(const LAS f32x2*)(L + T_AP + j * APS + 2 * n);
              v[2 * e2] = (f16)(cr * p.x - ci * p.y); v[2 * e2 + 1] = (f16)(-(cr * p.y + ci * p.x)); }
          return v; };
      f16x8 bf[4];
#pragma unroll
      for (int kk = 0; kk < 4; ++kk) bf[kk] = bfrag(dir, kk);
#pragma unroll 1
      for (int jj = 0; jj < 4; ++jj) { const int j = 4 * wave + jj;
          if (j == 0 && dir == 1) continue;
          f32x4 d = {0.f, 0.f, 0.f, 0.f};
#pragma unroll
          for (int kk = 0; kk < 4; ++kk) d = MFMA16(afrag(dir, kk, j, false), bf[kk], d);
          if (j == 0) {
#pragma unroll
              for (int kk = 0; kk < 4; ++kk) d = MFMA16(afrag(1, kk, 0, true), bfrag(1, kk), d); }
          const int li = dir == 0 ? 31 + j : 31 - j;
#pragma unroll
          for (int r = 0; r < 4; ++r) KTg[li * 256 + (4 * fq + r) * 16 + fr] = (f16)d[r]; } }
    { const int sp = lane >> 1, h0 = (lane & 1) * 8; const int e = dir == 0 ? TC - 1 - sp : sp;
      for (int jr = wave; jr < 128; jr += NWAVES) { const int ri = jr >> 6, n = jr & 63;
        const f32x2 p = *(const LAS f32x2*)(L + T_AP + e * APS + 2 * n);
        const LAS f32x4* brp = (const LAS f32x4*)(L + T_BR + dir * 1024 + n * 16 + h0); const LAS f32x4* bip = (const LAS f32x4*)(L + T_BI + dir * 1024 + n * 16 + h0);
        const f32x4 br0 = brp[0], br1 = brp[1], bi0 = bip[0], bi1 = bip[1];
        const f32x4 v0 = ri == 0 ? p.x * br0 - p.y * bi0 : p.x * bi0 + p.y * br0, v1 = ri == 0 ? p.x * br1 - p.y * bi1 : p.x * bi1 + p.y * br1;
        *(u32x4*)(PGg + (size_t)(dir * 128 + jr) * 512 + lane * 8) = pack8(v0, v1); } }
    { const int k0 = (lane & 15) * 8, ri = k0 >> 6, n0 = k0 & 63;
      for (int it = 0; it < 16; ++it) { const int nrow = wave * 64 + it * 4 + (lane >> 4), s = nrow >> 4, h = nrow & 15; const int e = dir == 0 ? s + 1 : TC - s;
        const LAS f32x4* crp = (const LAS f32x4*)(L + T_CR + dir * 1024 + h * 64 + n0); const LAS f32x4* cip = (const LAS f32x4*)(L + T_CI + dir * 1024 + h * 64 + n0);
        const LAS f32x4* app = (const LAS f32x4*)(L + T_AP + e * APS + 2 * n0);
        const f32x4 cr0 = crp[0], cr1 = crp[1], ci0 = cip[0], ci1 = cip[1], a0 = app[0], a1 = app[1], a2 = app[2], a3 = app[3];
        const f32x4 pr0 = {a0[0], a0[2], a1[0], a1[2]}, pi0 = {a0[1], a0[3], a1[1], a1[3]}, pr1 = {a2[0], a2[2], a3[0], a3[2]}, pi1 = {a2[1], a2[3], a3[1], a3[3]};
        const f32x4 v0 = ri == 0 ? cr0 * pr0 - ci0 * pi0 : -(cr0 * pi0 + ci0 * pr0), v1 = ri == 0 ? cr1 * pr1 - ci1 * pi1 : -(cr1 * pi1 + ci1 * pr1);
        *(u32x4*)(QGg + (size_t)nrow * 256 + dir * 128 + k0) = pack8(v0, v1); } }
    __syncthreads();
}
__device__ __forceinline__ void ssm_scan(LAS float* L, int item, const float* lam_re, const float* lam_im, const float* log_dt, const float* S, f16* X) {
    const int b = item >> 7, dir = (item >> 6) & 1, g = item & 63;
    const int tid = threadIdx.x, seg = tid >> 6, n = tid & 63, pg = dir * NG + g;
    const float dt = expf(log_dt[pg]), lr = lam_re[pg * NS + n], li = lam_im[pg * NS + n];
    float tr, ti, sr, si;
    { const float er = expf((float)TC * lr * dt); float sn, cs; sincosf((float)TC * (li * dt), &sn, &cs); tr = er * cs; ti = er * sn; }
    { const float er = expf((float)(33 * TC) * lr * dt); float sn, cs; sincosf((float)(33 * TC) * (li * dt), &sn, &cs); sr = er * cs; si = er * sn; }
    const float* Sg = S + (size_t)g * NCH * 256 + dir * 128 + n;
    f16* Xg = X + (size_t)g * XGS + dir * 128 + n;
    float vr[33], vi[33];
#pragma unroll
    for (int i = 0; i < 33; ++i) { const int p = seg * 33 + i;
        const int row = p < 8 ? NLC + b * 8 + (dir == 0 ? p : 7 - p) : b * 256 + (dir == 0 ? p - 8 : 255 - (p - 8));
        vr[i] = Sg[(size_t)row * 256]; vi[i] = Sg[(size_t)row * 256 + 64]; }
    __builtin_amdgcn_sched_barrier(0);
    float hr = 0.f, hi = 0.f;
#pragma unroll
    for (int i = 0; i < 33; ++i) { const float s_r = vr[i], s_i = vi[i]; vr[i] = hr; vi[i] = hi; const float nr = tr * hr - ti * hi + s_r, ni = tr * hi + ti * hr + s_i; hr = nr; hi = ni; }
    L[(seg * 64 + n) * 2] = hr; L[(seg * 64 + n) * 2 + 1] = hi;
    __syncthreads();
    float ir = 0.f, ii = 0.f;
    for (int k = 0; k < seg; ++k) { const float er = L[(k * 64 + n) * 2], ei = L[(k * 64 + n) * 2 + 1]; const float nr = sr * ir - si * ii + er, ni = sr * ii + si * ir + ei; ir = nr; ii = ni; }
    float pr = 1.f, pi = 0.f;
#pragma unroll
    for (int i = 0; i < 33; ++i) { const int p = seg * 33 + i;
        const float fr_ = vr[i] + pr * ir - pi * ii, fi_ = vi[i] + pr * ii + pi * ir;
        if (p >= 8) { const int row = b * 256 + (dir == 0 ? p - 8 : 255 - (p - 8)); Xg[(size_t)row * XK] = (f16)fr_; Xg[(size_t)row * XK + 64] = (f16)fi_; }
        const float npr = pr * tr - pi * ti, npi = pr * ti + pi * tr; pr = npr; pi = npi; }
    __syncthreads();
}

#define XB_TMO      128
#define XB_XCNT(j)  (256  + 64 * (j))
#define XB_XSUB(j)  (1280 + 64 * (j))
#define XB_XGEN(j)  (2304 + 64 * (j))
#define XB_TOP      3328
#define XB_TOPGEN   3392
#define XCD_BAR_WORDS 3456
#define XB_SPIN_CAP (1u << 18)
__device__ __forceinline__ unsigned xb_ld(unsigned* p)              { return __hip_atomic_load(p, __ATOMIC_RELAXED, __HIP_MEMORY_SCOPE_AGENT); }
__device__ __forceinline__ unsigned xb_add(unsigned* p, unsigned v) { return __hip_atomic_fetch_add(p, v, __ATOMIC_RELAXED, __HIP_MEMORY_SCOPE_AGENT); }
__device__ __forceinline__ unsigned xb_xcc_id() { return (unsigned)__builtin_amdgcn_s_getreg((3 << 11) | 20) & 0xFu; }
#define XB_SPIN(cond, bar) do { unsigned _sp = 0; while (cond) { __builtin_amdgcn_s_sleep(1); \
    if ((++_sp & 255u) == 0u) { if (xb_ld(&(bar)[XB_TMO])) break; if (_sp > XB_SPIN_CAP) { atomicAdd(&(bar)[XB_TMO], 1u); break; } } } } while (0)
struct XcdBarrier { unsigned* bar; unsigned x; volatile LAS unsigned* st; };
__device__ __forceinline__ XcdBarrier xcd_barrier_post(unsigned* bar, volatile LAS unsigned* st) {
    XcdBarrier b; b.bar = bar; b.x = xb_xcc_id(); b.st = st;
    if (threadIdx.x == 0) (void)xb_add(&bar[XB_XCNT(b.x)], 1u);
    return b;
}
__device__ __forceinline__ void xcd_barrier_complete(unsigned* bar, unsigned x, unsigned& nloc, unsigned& nx) {
    const unsigned G = gridDim.x * gridDim.y * gridDim.z;
    unsigned sum, cnt, mine, sp = 0u;
    for (;;) {
        sum = 0u; cnt = 0u; mine = 0u;
#pragma unroll
        for (unsigned j = 0; j < 16; ++j) { const unsigned c = xb_ld(&bar[XB_XCNT(j)]); sum += c; cnt += (c > 0u) ? 1u : 0u; mine = (j == x) ? c : mine; }
        if (sum == G) break;
        __builtin_amdgcn_s_sleep(1);
        if ((++sp & 255u) == 0u) { if (xb_ld(&bar[XB_TMO])) break; if (sp > XB_SPIN_CAP) { atomicAdd(&bar[XB_TMO], 1u); break; } }
    }
    nloc = mine > 0u ? mine : 1u; nx = cnt > 0u ? cnt : 1u;
}
__device__ __forceinline__ void xcd_barrier(const XcdBarrier& b) {
    asm volatile("s_waitcnt vmcnt(0)" ::: "memory");
    __syncthreads();
    if (threadIdx.x == 0) {
        unsigned* bar = b.bar;
        __builtin_amdgcn_s_waitcnt(0);
        unsigned nloc = b.st[0], nx = b.st[1];
        if (nloc == 0u) { xcd_barrier_complete(bar, b.x, nloc, nx); b.st[0] = nloc; b.st[1] = nx; }
        const unsigned old = xb_add(&bar[XB_XSUB(b.x)], 1u);
        const unsigned gen = old / nloc;
        if (old + 1u == (gen + 1u) * nloc) {
            __builtin_amdgcn_fence(__ATOMIC_RELEASE, "agent");
            asm volatile("s_waitcnt vmcnt(0)" ::: "memory");
            const unsigned og = xb_add(&bar[XB_TOP], 1u);
            const unsigned tg = og / nx;
            if (og + 1u == (tg + 1u) * nx) xb_add(&bar[XB_TOPGEN], 1u);
            else XB_SPIN(xb_ld(&bar[XB_TOPGEN]) == tg, bar);
            __builtin_amdgcn_fence(__ATOMIC_ACQUIRE, "agent");
            xb_add(&bar[XB_XGEN(b.x)], 1u);
            asm volatile("s_waitcnt vmcnt(0)" ::: "memory");
        } else {
            XB_SPIN(xb_ld(&bar[XB_XGEN(b.x)]) == gen, bar);
            __builtin_amdgcn_fence(__ATOMIC_ACQUIRE, "agent");
            asm volatile("s_waitcnt vmcnt(0)" ::: "memory");
        }
    }
    __syncthreads();
}
__device__ __forceinline__ int q_pop(unsigned* q, volatile LAS int* slot) {
    __syncthreads();
    if (threadIdx.x == 0) *slot = (int)__hip_atomic_fetch_add(q, 1u, __ATOMIC_RELAXED, __HIP_MEMORY_SCOPE_AGENT);
    __syncthreads();
    return *slot;
}
__device__ __forceinline__ float wave_sum(float v) {
#pragma unroll
    for (int o = 1; o < 64; o <<= 1) v += __shfl_xor(v, o);
    return v;
}

__device__ __forceinline__ void gemv_item(LAS float* L, int item, const float* c, const float* c_ctx, const float* ada_w, const float* ada_b, float* mod) {
    const int tid = threadIdx.x, wave = tid >> 6;
    for (int i = tid; i < 3 * D; i += NTHREADS) { const int r = i / D, k = i % D; const float v = r < 2 ? c[r * D + k] : c_ctx[k]; L[i] = v / (1.f + expf(-v)); }
    __syncthreads();
    const int l8 = tid & 7, rs = tid >> 3, n0 = item * 32;
    const float* wp = ada_w + n0 + 4 * l8;
    f32x4 a0 = {0.f, 0.f, 0.f, 0.f}, a1 = a0, a2 = a0;
    f32x4 wv[32];
#pragma unroll
    for (int i = 0; i < 32; ++i) wv[i] = ld_nt(wp + (size_t)(rs + 64 * i) * (3 * D));
    __builtin_amdgcn_sched_barrier(0);
#pragma unroll
    for (int i = 0; i < 32; ++i) { const int k = rs + 64 * i; a0 += L[k] * wv[i]; a1 += L[D + k] * wv[i]; a2 += L[2 * D + k] * wv[i]; }
#pragma unroll
    for (int e = 0; e < 4; ++e) {
#pragma unroll
        for (int o = 8; o < 64; o <<= 1) { a0[e] += __shfl_xor(a0[e], o); a1[e] += __shfl_xor(a1[e], o); a2[e] += __shfl_xor(a2[e], o); } }
    LAS float* red = L + 3 * D;
    if ((tid & 63) < 8) {
#pragma unroll
        for (int e = 0; e < 4; ++e) { red[wave * 96 + l8 * 4 + e] = a0[e]; red[wave * 96 + 32 + l8 * 4 + e] = a1[e]; red[wave * 96 + 64 + l8 * 4 + e] = a2[e]; } }
    __syncthreads();
    if (tid < 96) { float sum = 0.f;
#pragma unroll
        for (int w = 0; w < 8; ++w) sum += red[w * 96 + tid];
        const int r = tid >> 5, col = tid & 31; mod[r * 3 * D + n0 + col] = sum + ada_b[n0 + col]; }
    __syncthreads();
}
__device__ __forceinline__ void transpose_item(const float* W, int K, int N, f16* WT, LAS float* scr, int item, int lane) {
    const int nblk = N / 32, kb = item / nblk, nb = item % nblk, k0 = 64 * kb, n0 = 32 * nb;
    const int kr = lane >> 3, nq = (lane & 7) * 4;
    f32x4 v[8];
#pragma unroll
    for (int i = 0; i < 8; ++i) v[i] = ld_nt(W + (size_t)(k0 + kr + 8 * i) * N + n0 + nq);
    __builtin_amdgcn_sched_barrier(0);
#pragma unroll
    for (int i = 0; i < 8; ++i) { LAS float* sp = scr + (kr + 8 * i) * 33 + nq; sp[0] = v[i][0]; sp[1] = v[i][1]; sp[2] = v[i][2]; sp[3] = v[i][3]; }
    asm volatile("s_waitcnt lgkmcnt(0)" ::: "memory");
    const int c = lane & 7;
#pragma unroll
    for (int j = 0; j < 4; ++j) { const int n = (lane >> 3) + 8 * j; const LAS float* sp = scr + (8 * c) * 33 + n;
        u32x4 o; o.x = pk_f16(sp[0 * 33], sp[1 * 33]); o.y = pk_f16(sp[2 * 33], sp[3 * 33]); o.z = pk_f16(sp[4 * 33], sp[5 * 33]); o.w = pk_f16(sp[6 * 33], sp[7 * 33]);
        *(u32x4*)(WT + (size_t)(n0 + n) * K + k0 + 8 * c) = o; }
    asm volatile("s_waitcnt lgkmcnt(0)" ::: "memory");
}
constexpr int TI_IN = (D / 64) * (4096 / 32), TI_OUT = (D / 64) * (D / 32), TI_GLU = (SW / 64) * (2 * SW / 32), TI_POOL1 = (256 / 64) * (256 / 32), TI_ALL = TI_IN + TI_OUT + TI_GLU + 4 * TI_POOL1;
__device__ __forceinline__ void transpose_dispatch(int it, const float* in_w, const float* out_w, const float* glu_w, const float* pool_w, unsigned char* ws, LAS float* scr, int lane) {
    if (it < TI_IN) { transpose_item(in_w, D, 4096, (f16*)(ws + WS_WIN), scr, it, lane); return; } it -= TI_IN;
    if (it < TI_OUT) { transpose_item(out_w, D, D, (f16*)(ws + WS_WOUT), scr, it, lane); return; } it -= TI_OUT;
    if (it < TI_GLU) { transpose_item(glu_w, SW, 2 * SW, (f16*)(ws + WS_WGLU), scr, it, lane); return; } it -= TI_GLU;
    const int pg = it / TI_POOL1; transpose_item(pool_w + pg * 65536, 256, 256, (f16*)(ws + WS_WPOOL) + pg * 65536, scr, it % TI_POOL1, lane);
}
__device__ __forceinline__ void norm_rows(int gw, int lane, const float* x, const float* ctx, const float* ng, const float* mod, f16* h) {
    f32x4 gs[8], sh[8];
    auto load_mod = [&](int mr) { const float* shp = mod + mr * 3 * D;
#pragma unroll
        for (int j = 0; j < 8; ++j) { const int cidx = 256 * j + 4 * lane; const f32x4 g4 = *(const f32x4*)(ng + cidx), s4 = *(const f32x4*)(shp + D + cidx); gs[j] = g4 * (1.f + s4); sh[j] = *(const f32x4*)(shp + cidx); } };
    auto finish_row = [&](const f32x4 (&v)[8], f16* dst) { float ss = 0.f;
#pragma unroll
        for (int j = 0; j < 8; ++j) ss += (v[j][0] * v[j][0] + v[j][1] * v[j][1]) + (v[j][2] * v[j][2] + v[j][3] * v[j][3]);
        const float rstd = rsqrtf(wave_sum(ss) * (1.f / D) + EPS);
#pragma unroll
        for (int j = 0; j < 8; ++j) { const f32x4 o = v[j] * rstd * gs[j] + sh[j]; u32x2 w; w.x = pk_f16(o[0], o[1]); w.y = pk_f16(o[2], o[3]); *(u32x2*)(dst + 256 * j + 4 * lane) = w; } };
    constexpr int RPW = 8;
    const int r0 = gw * RPW;
    if (r0 < M_LAT) { load_mod(r0 / SEQ);
#pragma unroll 1
        for (int rb = r0; rb < r0 + RPW; rb += 4) { f32x4 v[4][8];
#pragma unroll
            for (int rr = 0; rr < 4; ++rr)
#pragma unroll
                for (int j = 0; j < 8; ++j) v[rr][j] = ld_nt(x + (size_t)(rb + rr) * D + 256 * j + 4 * lane);
            __builtin_amdgcn_sched_barrier(0);
#pragma unroll
            for (int rr = 0; rr < 4; ++rr) finish_row(v[rr], h + (size_t)(rb + rr) * D); } }
    if (gw < M_CTX) { load_mod(2); f32x4 v[8];
#pragma unroll
        for (int j = 0; j < 8; ++j) v[j] = ld_nt(ctx + (size_t)gw * D + 256 * j + 4 * lane);
        finish_row(v, h + (size_t)(M_LAT + gw) * D); }
}
typedef float f32x16 __attribute__((ext_vector_type(16)));
__device__ __forceinline__ void ctx_item(LAS float* L, int item, const f16* hc, const f16* Wssm, f16* X) {
    const int tid = threadIdx.x, wave = tid >> 6, lane = tid & 63, rb = item >> 4, cb = item & 15, k0 = wave * 256 + 8 * (lane >> 5);
    const f16* ap = hc + (size_t)(rb * 32 + (lane & 31)) * D + k0;
    const f16* bp0 = Wssm + (size_t)(cb * 64 + (lane & 31)) * D + k0; const f16* bp1 = bp0 + (size_t)32 * D;
    f32x16 acc0, acc1;
#pragma unroll
    for (int i = 0; i < 16; ++i) { acc0[i] = 0.f; acc1[i] = 0.f; }
#pragma unroll 1
    for (int kb = 0; kb < 16; kb += 8) { f16x8 av[8], b0[8], b1[8];
#pragma unroll
        for (int k = 0; k < 8; ++k) { av[k] = *(const f16x8*)(ap + (kb + k) * 16); b0[k] = *(const f16x8*)(bp0 + (kb + k) * 16); b1[k] = *(const f16x8*)(bp1 + (kb + k) * 16); }
        __builtin_amdgcn_sched_barrier(0);
#pragma unroll
        for (int k = 0; k < 8; ++k) { acc0 = MFMA32(av[k], b0[k], acc0); acc1 = MFMA32(av[k], b1[k], acc1); } }
#pragma unroll
    for (int r = 0; r < 16; ++r) { L[((wave * 2 + 0) * 16 + r) * 64 + lane] = acc0[r]; L[((wave * 2 + 1) * 16 + r) * 64 + lane] = acc1[r]; }
    __syncthreads();
#pragma unroll
    for (int i = 0; i < 4; ++i) { const int idx = tid + NTHREADS * i, ln = idx & 63, reg = (idx >> 6) & 15, t = idx >> 10; float sum = 0.f;
#pragma unroll
        for (int w = 0; w < 8; ++w) sum += L[((w * 2 + t) * 16 + reg) * 64 + ln];
        const int row = (reg & 3) + 8 * (reg >> 2) + 4 * (ln >> 5), ch = cb * 64 + t * 32 + (ln & 31);
        X[(size_t)(ch >> 4) * XGS + (size_t)(NLC + rb) * XK + 256 + row * 16 + (ch & 15)] = (f16)sum; }
    __syncthreads();
}
__device__ __forceinline__ void ctxs_item(int g, const f16* X, const f16* PG, float* S) {
    const int tid = threadIdx.x, wave = tid >> 6, lane = tid & 63, fr = lane & 15, fq = lane >> 4;
    const f16* ap = X + (size_t)g * XGS + (size_t)(NLC + fr) * XK + 256 + 8 * fq;
    const f16* bp = PG + (size_t)g * PGS + (size_t)(32 * wave + fr) * 512 + 8 * fq;
    f32x4 d0 = {0.f, 0.f, 0.f, 0.f}, d1 = d0;
#pragma unroll 1
    for (int kb = 0; kb < 16; kb += 8) { f16x8 av[8], b0[8], b1[8];
#pragma unroll
        for (int k = 0; k < 8; ++k) { av[k] = *(const f16x8*)(ap + (kb + k) * 32); b0[k] = *(const f16x8*)(bp + (kb + k) * 32); b1[k] = *(const f16x8*)(bp + 16 * 512 + (kb + k) * 32); }
        __builtin_amdgcn_sched_barrier(0);
#pragma unroll
        for (int k = 0; k < 8; ++k) { d0 = MFMA16(av[k], b0[k], d0); d1 = MFMA16(av[k], b1[k], d1); } }
    float* sp = S + ((size_t)g * NCH + NLC + 4 * fq) * 256 + 32 * wave + fr;
#pragma unroll
    for (int r = 0; r < 4; ++r) { sp[(size_t)r * 256] = d0[r]; sp[(size_t)r * 256 + 16] = d1[r]; }
}
__device__ __forceinline__ void pm_item(LAS float* Vs, int item, const f16* up, f16* pm) {
    const int tid = threadIdx.x, b = item >> 7, g = (item >> 5) & 3, band = item & 31, r0 = band * 4;
    const int w = 2 << g, lo_off = w >> 1, hi_off = w - lo_off;
    const int o = tid & 31, cs = tid >> 5;
    const size_t cbase = (size_t)b * SEQ * PW + g * 256 + o * 8;
    float rs[4][8];
#pragma unroll
    for (int q = 0; q < 4; ++q)
#pragma unroll
        for (int e = 0; e < 8; ++e) rs[q][e] = 0.f;
    int cur_lo = r0 - lo_off < 0 ? 0 : r0 - lo_off, cur_hi = cur_lo;
    for (int r = r0; r < r0 + 4; ++r) {
        const int rlo = r - lo_off < 0 ? 0 : r - lo_off, rhi = r + hi_off > ROWS ? ROWS : r + hi_off;
        u32x4 cen[4];
#pragma unroll
        for (int q = 0; q < 4; ++q) cen[q] = *(const u32x4*)(up + cbase + (size_t)(r * GW + cs + 16 * q) * PW);
        while (cur_hi < rhi) { const int nb = rhi - cur_hi < 4 ? rhi - cur_hi : 4; u32x4 t[4][4];
#pragma unroll
            for (int j = 0; j < 4; ++j) if (j < nb) {
#pragma unroll
                for (int q = 0; q < 4; ++q) t[j][q] = *(const u32x4*)(up + cbase + (size_t)((cur_hi + j) * GW + cs + 16 * q) * PW); }
            __builtin_amdgcn_sched_barrier(0);
#pragma unroll
            for (int j = 0; j < 4; ++j) if (j < nb) {
#pragma unroll
                for (int q = 0; q < 4; ++q) { f32x4 v0, v1; unpack8(t[j][q], v0, v1);
#pragma unroll
                    for (int e = 0; e < 4; ++e) { rs[q][e] += v0[e]; rs[q][4 + e] += v1[e]; } } }
            cur_hi += nb; }
        for (; cur_lo < rlo; ++cur_lo) {
#pragma unroll
            for (int q = 0; q < 4; ++q) { f32x4 v0, v1; unpack8(*(const u32x4*)(up + cbase + (size_t)(cur_lo * GW + cs + 16 * q) * PW), v0, v1);
#pragma unroll
                for (int e = 0; e < 4; ++e) { rs[q][e] -= v0[e]; rs[q][4 + e] -= v1[e]; } } }
        const float inv = 1.f / (float)(rhi - rlo);
#pragma unroll
        for (int q = 0; q < 4; ++q) { LAS f32x4* vp = (LAS f32x4*)(Vs + (cs + 16 * q) * 256 + o * 8);
            vp[0] = (f32x4){rs[q][0] * inv, rs[q][1] * inv, rs[q][2] * inv, rs[q][3] * inv}; vp[1] = (f32x4){rs[q][4] * inv, rs[q][5] * inv, rs[q][6] * inv, rs[q][7] * inv}; }
        __syncthreads();
#pragma unroll
        for (int q = 0; q < 4; ++q) { const int cc = cs + 16 * q; const int clo = cc - lo_off < 0 ? 0 : cc - lo_off, chi = cc + hi_off > GW ? GW : cc + hi_off;
            f32x4 s0 = {0.f, 0.f, 0.f, 0.f}, s1 = s0;
            for (int c2 = clo; c2 < chi; ++c2) { const LAS f32x4* vp = (const LAS f32x4*)(Vs + c2 * 256 + o * 8); s0 += vp[0]; s1 += vp[1]; }
            const float ic = 1.f / (float)(chi - clo);
            f32x4 u0, u1; unpack8(cen[q], u0, u1);
            *(u32x4*)(pm + cbase + (size_t)(r * GW + cc) * PW) = pack8(s0 * ic - u0, s1 * ic - u1); }
        __syncthreads();
    }
}
__device__ __forceinline__ void final_rows(int gw, int lane, const f16* xo, float* out, const float* fg, const float* rowss) {
    f32x4 g4[4][2];
#pragma unroll
    for (int j = 0; j < 4; ++j) { g4[j][0] = *(const f32x4*)(fg + 512 * j + 8 * lane); g4[j][1] = *(const f32x4*)(fg + 512 * j + 8 * lane + 4); }
#pragma unroll 1
    for (int r0 = gw * 8; r0 < gw * 8 + 8; r0 += 4) {
        u32x4 v[4][4]; float part[4];
#pragma unroll
        for (int rr = 0; rr < 4; ++rr) { part[rr] = lane < 32 ? rowss[(size_t)(r0 + rr) * 32 + lane] : 0.f;
#pragma unroll
            for (int j = 0; j < 4; ++j) v[rr][j] = *(const u32x4*)(xo + (size_t)(r0 + rr) * D + 512 * j + 8 * lane); }
        __builtin_amdgcn_sched_barrier(0);
#pragma unroll
        for (int rr = 0; rr < 4; ++rr) { const float rstd = rsqrtf(wave_sum(part[rr]) * (1.f / D) + EPS); float* rp = out + (size_t)(r0 + rr) * D + 8 * lane;
#pragma unroll
            for (int j = 0; j < 4; ++j) { f32x4 a0, a1; unpack8h(v[rr][j], a0, a1); *(f32x4*)(rp + 512 * j) = a0 * rstd * g4[j][0]; *(f32x4*)(rp + 512 * j + 4) = a1 * rstd * g4[j][1]; } }
    }
}

typedef pg8::Cfg<D / 64, 0, D * 2, (size_t)256 * D * 2, (size_t)128 * D * 2, 128, 0, D * 2, (size_t)256 * D * 2, (size_t)128 * D * 2, 128, 0> CfgDense2048;
typedef pg8::Cfg<512 / 64, 0, XK * 2, (size_t)256 * XK * 2, (size_t)128 * XK * 2, 128, XGS * 2, 512 * 2, 0, (size_t)128 * 512 * 2, 128, PGS * 2> CfgS;
typedef pg8::Cfg<256 / 64, 0, PW * 2, (size_t)256 * PW * 2, (size_t)128 * PW * 2, 128, 512, 256 * 2, 0, (size_t)128 * 256 * 2, 128, (size_t)65536 * 2> CfgPool;
typedef pg8::Cfg<XK / 64, 0, XK * 2, (size_t)256 * XK * 2, (size_t)128 * XK * 2, 128, XGS * 2, 512, (size_t)256 * 512, (size_t)128 * 512, 128, QGS * 2, 1> CfgY;
typedef pg8::Cfg<SW / 64, 1, (unsigned)(YGS * 2), (size_t)256 * 32, (size_t)128 * 32, 4 * YGS * 2, 0, SW * 2, (size_t)128 * SW * 2, (size_t)1024 * SW * 2, 128, 0> CfgGlu;

constexpr int CW_BAR = 0, CW_Q0 = 4096, CW_Q3 = 4096 + 64;
constexpr size_t CTL_ZERO_BYTES = 65536;
constexpr int MISC_OFF = 143360;

__global__ void __launch_bounds__(NTHREADS, 2) mk_fwd(Args a) {
    extern __shared__ __attribute__((aligned(16))) unsigned char lds_raw[];
    LAS unsigned char* lds = (LAS unsigned char*)lds_raw;
    volatile LAS unsigned* MISC = (volatile LAS unsigned*)(lds + MISC_OFF);
    const int G = gridDim.x, bx = blockIdx.x, tid = threadIdx.x, lane = tid & 63, wave = __builtin_amdgcn_readfirstlane(tid >> 6);
    const int vcu = (G % 8 == 0) ? (bx % 8) * (G / 8) + bx / 8 : bx;
    const int lo = a.ph_lo, hi = a.ph_hi;
    unsigned* ctl = (unsigned*)(a.ws + WS_CTL);
    if (tid < 16) MISC[tid] = 0u;
    __syncthreads();
    XcdBarrier bar = xcd_barrier_post(ctl + CW_BAR, MISC);
#define IN(k) (lo <= (k) && (k) < hi)
#define SEAM(k) do { if (IN(k) && IN((k) + 1)) xcd_barrier(bar); } while (0)
#define PHASE(k, ...) do { if (PROBE_PH == (k) && PROBE_SUB < 0) tp0 = __builtin_amdgcn_s_memrealtime(); if (IN(k)) { constexpr int rep = 0; constexpr int phk = (k); (void)rep; (void)phk; __VA_ARGS__ } \
    if (REPEAT_PH == (k) && IN(k)) { xcd_barrier(bar); constexpr int rep = 1; constexpr int phk = (k); (void)rep; (void)phk; __VA_ARGS__ } if (PROBE_PH == (k) && PROBE_SUB == 9) tp0 = __builtin_amdgcn_s_memrealtime(); SEAM(k); if (PROBE_PH == (k) && PROBE_SUB == 9) tp1 = __builtin_amdgcn_s_memrealtime(); if (PROBE_PH == (k) && PROBE_SUB < 0) tp1 = __builtin_amdgcn_s_memrealtime(); } while (0)
#define SUB(i, ...) do { if (PROBE_PH == phk && PROBE_SUB == (i)) { __syncthreads(); tp0 = __builtin_amdgcn_s_memrealtime(); } __VA_ARGS__ if (PROBE_PH == phk && PROBE_SUB == (i)) { asm volatile("s_waitcnt vmcnt(0)" ::: "memory"); __syncthreads(); tp1 = __builtin_amdgcn_s_memrealtime(); } } while (0)
    unsigned long long tp0 = 0, tp1 = 0;
    if (PROBE_PH == 99) tp0 = __builtin_amdgcn_s_memrealtime();
    PHASE(0,
        int tcount; int tstart;
        if (bx < 128) { tcount = 3; tstart = 3 * bx; } else if (bx < 192) { tcount = 1; tstart = 384 + (bx - 128); } else { tcount = 7; tstart = 448 + 7 * (bx - 192); }
        SUB(0, if (bx < 128) ssm_tables((LAS float*)lds, bx, a.in[10], a.in[11], a.in[12], a.in[13], a.in[14], a.in[15], a.in[16], (f16*)(a.ws + WS_PG), (f16*)(a.ws + WS_QG), (f16*)(a.ws + WS_KTH));
               else { gemv_item((LAS float*)lds, bx - 128, a.in[1], a.in[3], a.in[4], a.in[5], (float*)(a.ws + WS_MOD));
                      if (bx < 192) gemv_item((LAS float*)lds, bx, a.in[1], a.in[3], a.in[4], a.in[5], (float*)(a.ws + WS_MOD)); } );
        LAS float* scr = (LAS float*)lds + wave * (64 * 33);
        SUB(1, for (int it = tstart; it < tstart + tcount; ++it) transpose_dispatch(it * 8 + wave, a.in[7], a.in[20], a.in[18], a.in[8], a.ws, scr, lane);
               if (bx >= 240) transpose_dispatch((896 + bx - 240) * 8 + wave, a.in[7], a.in[20], a.in[18], a.in[8], a.ws, scr, lane); );
    );
    PHASE(1, norm_rows(vcu * NWAVES + wave, lane, a.in[0], a.in[2], a.in[6], (const float*)(a.ws + WS_MOD), (f16*)(a.ws + WS_H)); );
    PHASE(2,
        pg8::DenseOrder S; S.init(M_LAT / 256, 4096 / 256, G, bx);
        EpiInProj E{(f16*)(a.ws + WS_UPOOL), (f16*)(a.ws + WS_X), (f16*)(a.ws + WS_ZS)};
        SUB(0, pg8::gemm_phase<CfgDense2048, EpiInProj, pg8::DenseOrder, true, true>(lds, (const char*)(a.ws + WS_H), (const char*)(a.ws + WS_WIN), S, E); );
        for (int it = bx; it < 256; it += G) ctx_item((LAS float*)lds, it, (const f16*)(a.ws + WS_H) + (size_t)M_LAT * D, (const f16*)(a.ws + WS_WIN) + (size_t)PW * D, (f16*)(a.ws + WS_X));
    );
    PHASE(3,
        { pg8::ListOrder S; S.init(NG * 2, 2, 1, G, vcu);
          EpiS E{(float*)(a.ws + WS_S)};
          SUB(0, pg8::gemm_phase<CfgS, EpiS, pg8::ListOrder, true, true>(lds, (const char*)(a.ws + WS_X + 512), (const char*)(a.ws + WS_PG), S, E);
                 if (vcu >= 128 && vcu < 192) ctxs_item(vcu - 128, (const f16*)(a.ws + WS_X), (const f16*)(a.ws + WS_PG), (float*)(a.ws + WS_S)); ); }
        { const int v = vcu & 255; const int pgp = v < 128 ? (v >> 6) : 2 + ((v - 128) >> 6), rest = v & 63, pb = rest >> 5, band = rest & 31;
            SUB(1, pm_item((LAS float*)lds, (pb << 7) | (pgp << 5) | band, (const f16*)(a.ws + WS_UPOOL), (f16*)(a.ws + WS_PM)); );
            asm volatile("s_waitcnt vmcnt(0)" ::: "memory"); __syncthreads();
            pg8::OneUnit S1; S1.u.g = pgp; S1.u.pm = pb * 32 + band; S1.u.pn = 0; S1.have = true;
            EpiPool E{(f16*)(a.ws + WS_BRANCH), (const f16*)(a.ws + WS_ZS), a.in[9]};
            SUB(2, pg8::gemm_phase<CfgPool, EpiPool, pg8::OneUnit, true, true>(lds, (const char*)(a.ws + WS_PM), (const char*)(a.ws + WS_WPOOL), S1, E); ); }
    );
    PHASE(4,
        SUB(0, for (int it = bx; it < 256; it += G) ssm_scan((LAS float*)lds, it, a.in[10], a.in[11], a.in[12], (const float*)(a.ws + WS_S), (f16*)(a.ws + WS_X)); );
    );
    PHASE(5,
        pg8::ListOrder S; S.init(NG * 4, 2, 2, G, vcu);
        EpiY E{(f16*)(a.ws + WS_YG), (const f16*)(a.ws + WS_X), a.in[17]};
        pg8::gemm_phase<CfgY, EpiY, pg8::ListOrder, true, true>(lds, (const char*)(a.ws + WS_X), (const char*)(a.ws + WS_QG), S, E, (const char*)(a.ws + WS_KTH));
    );
    PHASE(6,
        pg8::DenseOrder S; S.init(M_LAT / 256, SW / 128, G, bx);
        EpiGlu E{(f16*)(a.ws + WS_BRANCH), (const f16*)(a.ws + WS_ZS), a.in[19]};
        pg8::gemm_phase<CfgGlu, EpiGlu, pg8::DenseOrder, true, true>(lds, (const char*)(a.ws + WS_YG), (const char*)(a.ws + WS_WGLU), S, E);
    );
    PHASE(7,
        pg8::DenseOrder S; S.init(M_LAT / 256, D / 256, G, bx);
        EpiOut E{a.in[0], (f16*)(a.ws + WS_XO), (const float*)(a.ws + WS_MOD), (float*)(a.ws + WS_ROWSS)};
        pg8::gemm_phase<CfgDense2048, EpiOut, pg8::DenseOrder, true, true>(lds, (const char*)(a.ws + WS_BRANCH), (const char*)(a.ws + WS_WOUT), S, E);
    );
    if (PROBE_PH == 8) tp0 = __builtin_amdgcn_s_memrealtime();
    if (IN(8)) final_rows(vcu * NWAVES + wave, lane, (const f16*)(a.ws + WS_XO), a.out, a.in[21], (const float*)(a.ws + WS_ROWSS));
    if (PROBE_PH == 8) { asm volatile("s_waitcnt vmcnt(0)" ::: "memory"); tp1 = __builtin_amdgcn_s_memrealtime(); }
    if (PROBE_PH == 99) { asm volatile("s_waitcnt vmcnt(0)" ::: "memory"); tp1 = __builtin_amdgcn_s_memrealtime(); }
    if (PROBE_PH >= 0 && bx == PROBE_BX && tid == 0) { const unsigned long long t0 = __builtin_amdgcn_s_memrealtime(), span = (tp1 - tp0) * PROBE_MULT; while (__builtin_amdgcn_s_memrealtime() - t0 < span) __builtin_amdgcn_s_sleep(8); }
#undef PHASE
#undef SUB
#undef IN
#undef SEAM
}

#ifndef MK_SPLIT
#define MK_SPLIT 0
#endif
extern "C" void kernel_launch(void* const* d_in, const int* in_sizes, int n_in, void* d_out, int out_size, void* d_ws, size_t ws_size, hipStream_t stream) {
    static int grid = 0;
    if (grid == 0) {
        if (ws_size < WS_END + MiB || n_in != 22) { fprintf(stderr, "kernel_launch: unexpected workspace / inputs: %zu %d\n", ws_size, n_in); grid = -1; return; }
        if (hipFuncSetAttribute((const void*)mk_fwd, hipFuncAttributeMaxDynamicSharedMemorySize, LDS_BYTES) != hipSuccess) { fprintf(stderr, "hipFuncSetAttribute failed\n"); grid = -1; return; }
        int dev = 0, cus = 0, per_cu = 0;
        if (hipGetDevice(&dev) != hipSuccess || hipDeviceGetAttribute(&cus, hipDeviceAttributeMultiprocessorCount, dev) != hipSuccess) { grid = -1; return; }
        if (hipOccupancyMaxActiveBlocksPerMultiprocessor(&per_cu, (const void*)mk_fwd, NTHREADS, LDS_BYTES) != hipSuccess || per_cu < 1) { fprintf(stderr, "occupancy query: %d\n", per_cu); (void)hipGetLastError(); }
        if (cus < 256) { fprintf(stderr, "kernel_launch: built for a 256-CU device (got %d)\n", cus); grid = -1; return; }
        grid = 256;
    }
    if (grid < 0) return;
    if (hipMemsetAsync((char*)d_ws + WS_CTL, 0, CTL_ZERO_BYTES, stream) != hipSuccess) return;
    Args a{}; for (int i = 0; i < 22; ++i) a.in[i] = (const float*)d_in[i]; a.out = (float*)d_out; a.ws = (unsigned char*)d_ws;
#if MK_SPLIT
    for (int ph = 0; ph < 9; ++ph) { a.ph_lo = ph; a.ph_hi = ph + 1; hipLaunchKernelGGL(mk_fwd, dim3(grid), dim3(NTHREADS), LDS_BYTES, stream, a); }
#else
    a.ph_lo = 0; a.ph_hi = 9; hipLaunchKernelGGL(mk_fwd, dim3(grid), dim3(NTHREADS), LDS_BYTES, stream, a);
#endif
}
```

```cpp
#include <hip/hip_runtime.h>
#include <cstdint>
#include <cstdio>
#ifndef WGM_IN
#define WGM_IN 4
#endif
#ifndef WGM_GLU
#define WGM_GLU 1
#endif
#ifndef WGM_OUT
#define WGM_OUT 1
#endif
#ifndef PROBE_PH
#define PROBE_PH (-1)
#endif
#ifndef PROBE_SUB
#define PROBE_SUB (-1)
#endif
#define PROBE_MULT 8
#ifndef PROBE_BX
#define PROBE_BX 0
#endif
#ifndef REPEAT_PH
#define REPEAT_PH (-1)
#endif

#define LAS __attribute__((address_space(3)))
#ifndef OP_BF16
#define OP_BF16 1
#endif
#if OP_BF16
typedef __bf16 f16;
typedef __bf16 f16x8 __attribute__((ext_vector_type(8)));
typedef __bf16 f16x2 __attribute__((ext_vector_type(2)));
#define MFMA16(a, b, c) __builtin_amdgcn_mfma_f32_16x16x32_bf16(a, b, c, 0, 0, 0)
#define MFMA32(a, b, c) __builtin_amdgcn_mfma_f32_32x32x16_bf16(a, b, c, 0, 0, 0)
#else
typedef _Float16 f16;
typedef _Float16 f16x8 __attribute__((ext_vector_type(8)));
typedef _Float16 f16x2 __attribute__((ext_vector_type(2)));
#define MFMA16(a, b, c) __builtin_amdgcn_mfma_f32_16x16x32_f16(a, b, c, 0, 0, 0)
#define MFMA32(a, b, c) __builtin_amdgcn_mfma_f32_32x32x16_f16(a, b, c, 0, 0, 0)
#endif
typedef float f32x4 __attribute__((ext_vector_type(4)));
typedef float f32x2 __attribute__((ext_vector_type(2)));
typedef unsigned u32x4 __attribute__((ext_vector_type(4)));
typedef unsigned u32x2 __attribute__((ext_vector_type(2)));

__device__ __forceinline__ unsigned pk_f16(float lo, float hi) { f16x2 v; v.x = (f16)lo; v.y = (f16)hi; return __builtin_bit_cast(unsigned, v); }
__device__ __forceinline__ float f16lo(unsigned w) { f16x2 v = __builtin_bit_cast(f16x2, w); return (float)v.x; }
__device__ __forceinline__ float f16hi(unsigned w) { f16x2 v = __builtin_bit_cast(f16x2, w); return (float)v.y; }
typedef _Float16 h16x2 __attribute__((ext_vector_type(2)));
__device__ __forceinline__ unsigned pk_h16(float lo, float hi) { h16x2 v; v.x = (_Float16)lo; v.y = (_Float16)hi; return __builtin_bit_cast(unsigned, v); }
__device__ __forceinline__ float h16lo(unsigned w) { h16x2 v = __builtin_bit_cast(h16x2, w); return (float)v.x; }
__device__ __forceinline__ float h16hi(unsigned w) { h16x2 v = __builtin_bit_cast(h16x2, w); return (float)v.y; }
__device__ __forceinline__ f32x4 ld_nt(const float* p) { return __builtin_nontemporal_load((const f32x4*)p); }
__device__ __forceinline__ float fast_sigmoid(float v) { return __builtin_amdgcn_rcpf(1.f + __expf(-v)); }
__device__ __forceinline__ float silu_f(float v) { return v * fast_sigmoid(v); }
__device__ __forceinline__ float gelu_tanh_f(float y) { const float t = 0.7978845608028654f * (y + 0.044715f * y * y * y); return y * fast_sigmoid(2.f * t); }

constexpr int D = 2048, BATCH = 2, SEQ = 8192, CTX = 256, GW = 64, ROWS = SEQ / GW;
constexpr int M_LAT = BATCH * SEQ, M_CTX = BATCH * CTX, M_ALL = M_LAT + M_CTX;
constexpr int PW = 1024, SW = 1024, NG = 64, NS = 64, GH = 16;
constexpr int TC = 32;
constexpr int NLC = M_LAT / TC;
constexpr int NCC = M_CTX / TC;
constexpr int NCH = NLC + NCC;
constexpr int XK = 256 + TC * GH;
constexpr float EPS = 1e-6f;
constexpr int NWAVES = 8, NTHREADS = 512;

constexpr size_t MiB = 1u << 20;
constexpr size_t WS_CTL = 0;
constexpr size_t WS_MOD = 1 * MiB;
constexpr size_t WS_ROWSS = 2 * MiB;
constexpr size_t WS_WIN = 4 * MiB;
constexpr size_t WS_WOUT = 20 * MiB;
constexpr size_t WS_WGLU = 28 * MiB;
constexpr size_t WS_WPOOL = 32 * MiB;
constexpr size_t WS_PG = 33 * MiB;
constexpr size_t WS_QG = 49 * MiB;
constexpr size_t WS_KTH = 65 * MiB;
constexpr size_t WS_H = 97 * MiB;
constexpr size_t WS_BRANCH = WS_H;
constexpr size_t WS_XO = 163 * MiB;
constexpr size_t WS_UPOOL = 163 * MiB;
constexpr size_t WS_X = 195 * MiB;
constexpr size_t WS_ZS = 246 * MiB;
constexpr size_t WS_PM = 310 * MiB;
constexpr size_t WS_S = 342 * MiB;
constexpr size_t WS_YG = 376 * MiB;
constexpr size_t WS_YF = 408 * MiB;
constexpr size_t WS_END = 472 * MiB;
constexpr size_t XGS = (size_t)NCH * XK;
constexpr size_t YGS = (size_t)M_LAT * GH;
constexpr size_t QGS = (size_t)512 * 256;
constexpr size_t PGS = (size_t)256 * 512;

namespace pg8 {
constexpr int BM = 256, BK = 64, HALF = 128, HTB = HALF * BK * 2, STAGE_BYTES = 8 * HTB, NXCD = 8, WGM = 8;
__host__ __device__ __forceinline__ int lds_byte(int r, int c) { const int st = (r >> 4) * 2 + (c >> 5), rr = r & 15, cc = c & 31, ob = rr * 64 + cc * 2; return st * 1024 + (ob ^ (((ob >> 9) & 1) << 5)); }
__host__ __device__ __forceinline__ void stage_rc(int b, int& R, int& C) { const int st = b / 1024, sb = b % 1024, swz = sb ^ (((sb >> 9) & 1) << 5); R = (st >> 1) * 16 + swz / 64; C = (st & 1) * 32 + (swz % 64) / 2; }
__host__ __device__ __forceinline__ int perm32(int rho) { const int n = rho >> 4, i = rho & 15; return 8 * (i >> 2) + 4 * n + (i & 3); }

struct Unit { int pm, pn, g; };
template <int NT_, int AMODE_, unsigned A_ROW_, size_t A_T_, size_t A_H_, size_t A_K_, size_t A_G_, unsigned B_ROW_, size_t B_T_, size_t B_H_, size_t B_K_, size_t B_G_, int BMODE_ = 0>
struct Cfg { static constexpr int NT = NT_, AMODE = AMODE_, BMODE = BMODE_; static constexpr unsigned A_ROW = A_ROW_, B_ROW = B_ROW_; static constexpr size_t A_T = A_T_, A_H = A_H_, A_K = A_K_, A_G = A_G_, B_T = B_T_, B_H = B_H_, B_K = B_K_, B_G = B_G_; };
constexpr size_t KTG = 63 * 512;

struct DenseOrder {
    int nM, nN, nwg, G, c, wgm;
    __device__ void init(int nM_, int nN_, int G_, int c_, int wgm_) { nM = nM_; nN = nN_; nwg = nM * nN; G = G_; c = c_; wgm = wgm_; }
    __device__ bool next(int i, Unit& u) const {
        const long L = (long)i * G + c; if (L >= nwg) return false;
        int wgid = (int)L; { const int q = nwg / NXCD, r = nwg % NXCD, xcd = wgid % NXCD, off = wgid / NXCD; wgid = (xcd < r ? xcd * (q + 1) : r * (q + 1) + (xcd - r) * q) + off; }
        const int nig = wgm * nN, gid = wgid / nig, fm = gid * wgm, gsz = (nM - fm) < wgm ? (nM - fm) : wgm;
        u.pm = fm + ((wgid % nig) % gsz); u.pn = (wgid % nig) / gsz; u.g = 0; return true;
    }
};
struct ListOrder {
    int n, npm, npn, G, vc;
    __device__ void init(int n_, int npm_, int npn_, int G_, int vc_) { n = n_; npm = npm_; npn = npn_; G = G_; vc = vc_; }
    __device__ bool next(int i, Unit& u) const { const int L = i * G + vc; if (L >= n) return false; u.g = L / (npm * npn); u.pm = (L / npn) % npm; u.pn = L % npn; return true; }
};

struct OneUnit { Unit u; bool have;
    __device__ bool next(int i, Unit& o) const { if (i != 0 || !have) return false; o = u; return true; } };

template <class CF, class Epi, class Sched, bool ALIGN_EPI, bool SP2>
__device__ __forceinline__ void gemm_phase(LAS unsigned char* lds, const char* gA, const char* gB, const Sched& S, const Epi& E, const char* gB2 = nullptr) {
    constexpr int AMODE = CF::AMODE, BMODE = CF::BMODE;
    static_assert(SP2, "only the two-super-phase loop is kept");
    const int tid = threadIdx.x, wid = __builtin_amdgcn_readfirstlane(tid >> 6), lane = tid & 63, wr = wid >> 2, wc = wid & 3, fr = lane & 15, fq = lane >> 4;
    constexpr int nt = CF::NT;
    unsigned voffA, voffB, voffT = 0;
    { int R, C; stage_rc(tid * 16, R, C); const int Rb = Epi::PERM ? ((R & ~31) + perm32(R & 31)) : R;
      voffA = AMODE == 0 ? (unsigned)R * CF::A_ROW + (unsigned)C * 2u : (unsigned)(C >> 4) * CF::A_ROW + (unsigned)R * 32u + (unsigned)(C & 15) * 2u;
      voffB = (unsigned)Rb * CF::B_ROW + (unsigned)C * 2u;
      if constexpr (BMODE == 1) voffT = (unsigned)Rb * 32u + 1536u - (unsigned)(C >> 4) * 512u + (unsigned)(C & 15) * 2u; }
    constexpr size_t a64 = AMODE == 0 ? (size_t)64 * CF::A_ROW : (size_t)64 * 32, b64 = (size_t)64 * CF::B_ROW, t64 = (size_t)64 * 32;
    constexpr size_t akstep = CF::A_K, bkstep = CF::B_K, ahstep = CF::A_H, bhstep = CF::B_H;
    const unsigned ldsw = (unsigned)wid * 1024u;
    const int aoff = lds_byte(wr * 64 + fr, fq * 8), boff = lds_byte(wc * 32 + fr, fq * 8);
#define PG8_SA(b, h) (((b) * 2 + (h)) * HTB)
#define PG8_SB(b, h) ((4 + (b) * 2 + (h)) * HTB)
#define PG8_STAGE(bufoff, gbase, voff, step64) do { \
        __builtin_amdgcn_global_load_lds((const unsigned*)((const char*)(gbase) + (voff)), (LAS unsigned*)(lds + (bufoff) + ldsw), 16, 0, 0); \
        __builtin_amdgcn_global_load_lds((const unsigned*)((const char*)(gbase) + (step64) + (voff)), (LAS unsigned*)(lds + (bufoff) + ldsw + 8192), 16, 0, 0); } while (0)
#define PG8_STAGE_A(bufoff, gbase) PG8_STAGE(bufoff, gbase, voffA, a64)
#define PG8_STAGE_B(bufoff, bp, hb, tz) do { if (BMODE == 1 && (tz)) PG8_STAGE(bufoff, (bp) + (hb) * 4096, voffT, t64); else PG8_STAGE(bufoff, (bp) + (hb) * bhstep, voffB, b64); } while (0)
#define PG8_LDA(dst, b, h) do { _Pragma("unroll") for (int m = 0; m < 4; ++m) _Pragma("unroll") for (int k = 0; k < 2; ++k) dst[m][k] = *(const LAS f16x8*)(lds + PG8_SA(b, h) + aoff + m * 2048 + k * 1024); } while (0)
#define PG8_LDB(dst, b, h) do { _Pragma("unroll") for (int n = 0; n < 2; ++n) _Pragma("unroll") for (int k = 0; k < 2; ++k) dst[n][k] = *(const LAS f16x8*)(lds + PG8_SB(b, h) + boff + n * 2048 + k * 1024); } while (0)
#define PG8_MMA(ai, bj, At, Bt) do { __builtin_amdgcn_s_setprio(1); _Pragma("unroll") for (int m = 0; m < 4; ++m) _Pragma("unroll") for (int n = 0; n < 2; ++n) _Pragma("unroll") for (int k = 0; k < 2; ++k) \
        acc[ai][bj][m][n] = MFMA16(Bt[n][k], At[m][k], acc[ai][bj][m][n]); __builtin_amdgcn_s_setprio(0); } while (0)
#define PG8_WAIT_V(n) asm volatile("s_waitcnt vmcnt(" #n ")" ::: "memory")
#define PG8_WAIT_L(n) asm volatile("s_waitcnt lgkmcnt(" #n ")" ::: "memory")
#define PG8_BAR __builtin_amdgcn_s_barrier()
#define PG8_SCHED __builtin_amdgcn_sched_barrier(0)
    Unit cur, nxt; int ui = 0;
    if (!S.next(0, cur)) return;
    f32x4 acc[2][2][4][2];
#pragma unroll
    for (int a = 0; a < 2; ++a)
#pragma unroll
        for (int b = 0; b < 2; ++b)
#pragma unroll
            for (int m = 0; m < 4; ++m)
#pragma unroll
                for (int n = 0; n < 2; ++n) acc[a][b][m][n] = (f32x4){0.f, 0.f, 0.f, 0.f};
    f16x8 At[4][2], B0[2][2], B1[2][2];
    const char* cA = gA + (size_t)cur.g * CF::A_G + (size_t)cur.pm * CF::A_T; const char* cB = gB + (size_t)cur.g * CF::B_G + (size_t)cur.pn * CF::B_T;
    const char* cT = BMODE == 1 ? gB2 + (size_t)cur.g * KTG + (size_t)cur.pn * 8192 + 14336 : nullptr;
    PG8_STAGE_B(PG8_SB(0, 0), cB, 0, false); PG8_STAGE_B(PG8_SB(0, 1), cB, 1, false); PG8_STAGE_A(PG8_SA(0, 0), cA); PG8_STAGE_A(PG8_SA(0, 1), cA + ahstep);
    if (wr == 1) PG8_BAR;
    PG8_WAIT_V(2); PG8_BAR;
    PG8_STAGE_B(PG8_SB(1, 0), cB + bkstep, 0, false); PG8_STAGE_A(PG8_SA(1, 0), cA + akstep); PG8_STAGE_B(PG8_SB(1, 1), cB + bkstep, 1, false);
    PG8_WAIT_V(6); PG8_BAR;
    for (;;) {
        const bool has_next = S.next(ui + 1, nxt);
        const char* nA = has_next ? gA + (size_t)nxt.g * CF::A_G + (size_t)nxt.pm * CF::A_T : cA; const char* nB = has_next ? gB + (size_t)nxt.g * CF::B_G + (size_t)nxt.pn * CF::B_T : cB;
        for (int t = 0; t < nt; t += 2) {
            const bool last = (t == nt - 2);
            const bool tz = BMODE == 1 && !last && (t + 2 >= 4);
            const char* a1 = cA + (size_t)(t + 1) * akstep;
            const char* a2 = last ? nA : cA + (size_t)(t + 2) * akstep;
            const char* b2 = last ? nB : (tz ? cT - (size_t)(t - 2) * 2048 : cB + (size_t)(t + 2) * bkstep);
            const char* a3 = a2 + akstep; const char* b3 = tz ? b2 - 2048 : b2 + bkstep;
            PG8_LDB(B0, 0, 0); PG8_LDB(B1, 0, 1); PG8_SCHED; PG8_LDA(At, 0, 0); PG8_STAGE_A(PG8_SA(1, 1), a1 + ahstep);
            PG8_WAIT_V(8); PG8_WAIT_L(0); PG8_BAR; PG8_MMA(0, 0, At, B0); PG8_MMA(0, 1, At, B1); PG8_BAR; PG8_SCHED;
            PG8_LDA(At, 0, 1); PG8_STAGE_B(PG8_SB(0, 0), b2, 0, tz); PG8_STAGE_B(PG8_SB(0, 1), b2, 1, tz); PG8_STAGE_A(PG8_SA(0, 0), a2);
            PG8_WAIT_V(8); PG8_WAIT_L(0); PG8_BAR; PG8_MMA(1, 0, At, B0); PG8_MMA(1, 1, At, B1); PG8_BAR; PG8_SCHED;
            PG8_LDB(B0, 1, 0); PG8_LDB(B1, 1, 1); PG8_SCHED; PG8_LDA(At, 1, 0); PG8_STAGE_A(PG8_SA(0, 1), a2 + ahstep);
            PG8_WAIT_V(8); PG8_WAIT_L(0); PG8_BAR; PG8_MMA(0, 0, At, B0); PG8_MMA(0, 1, At, B1); PG8_BAR; PG8_SCHED;
            PG8_LDA(At, 1, 1); PG8_STAGE_B(PG8_SB(1, 0), b3, 0, tz); PG8_STAGE_B(PG8_SB(1, 1), b3, 1, tz); PG8_STAGE_A(PG8_SA(1, 0), a3);
            PG8_WAIT_V(8); PG8_WAIT_L(0); PG8_BAR; PG8_MMA(1, 0, At, B0); PG8_MMA(1, 1, At, B1); PG8_BAR; PG8_SCHED;
        }
        if constexpr (ALIGN_EPI) { if (wr == 0) PG8_BAR; }
        E(acc, cur, wr, wc, fr, fq);
        if (!has_next) break;
#pragma unroll
        for (int a = 0; a < 2; ++a)
#pragma unroll
            for (int b = 0; b < 2; ++b)
#pragma unroll
                for (int m = 0; m < 4; ++m)
#pragma unroll
                    for (int n = 0; n < 2; ++n) acc[a][b][m][n] = (f32x4){0.f, 0.f, 0.f, 0.f};
        cur = nxt; cA = nA; cB = nB; ++ui;
        if constexpr (BMODE == 1) cT = gB2 + (size_t)cur.g * KTG + (size_t)cur.pn * 8192 + 14336;
        if constexpr (ALIGN_EPI) { if (wr == 1) PG8_BAR; }
    }
    PG8_WAIT_V(0);
    if constexpr (!ALIGN_EPI) { if (wr == 0) PG8_BAR; }
    PG8_BAR;
#undef PG8_SA
#undef PG8_SB
#undef PG8_STAGE
#undef PG8_STAGE_A
#undef PG8_STAGE_B
#undef PG8_LDA
#undef PG8_LDB
#undef PG8_MMA
#undef PG8_WAIT_V
#undef PG8_WAIT_L
#undef PG8_BAR
#undef PG8_SCHED
}
}
using pg8::Unit;
using pg8::HALF;
typedef const f32x4 (&AccRef)[2][2][4][2];

__device__ __forceinline__ u32x4 pack8(const f32x4 v0, const f32x4 v1) { u32x4 w; w.x = pk_f16(v0[0], v0[1]); w.y = pk_f16(v0[2], v0[3]); w.z = pk_f16(v1[0], v1[1]); w.w = pk_f16(v1[2], v1[3]); return w; }
__device__ __forceinline__ u32x4 pack8h(const f32x4 v0, const f32x4 v1) { u32x4 w; w.x = pk_h16(v0[0], v0[1]); w.y = pk_h16(v0[2], v0[3]); w.z = pk_h16(v1[0], v1[1]); w.w = pk_h16(v1[2], v1[3]); return w; }
__device__ __forceinline__ void unpack8h(const u32x4 w, f32x4& v0, f32x4& v1) { v0 = (f32x4){h16lo(w.x), h16hi(w.x), h16lo(w.y), h16hi(w.y)}; v1 = (f32x4){h16lo(w.z), h16hi(w.z), h16lo(w.w), h16hi(w.w)}; }
__device__ __forceinline__ void unpack8(const u32x4 w, f32x4& v0, f32x4& v1) { v0 = (f32x4){f16lo(w.x), f16hi(w.x), f16lo(w.y), f16hi(w.y)}; v1 = (f32x4){f16lo(w.z), f16hi(w.z), f16lo(w.w), f16hi(w.w)}; }

struct EpiInProj {
    static constexpr bool PERM = true;
    f16* upool; f16* X; f16* zs;
    __device__ __forceinline__ void operator()(AccRef acc, const Unit& u, int wr, int wc, int fr, int fq) const {
        int row0 = u.pm * 256 + wr * 64 + fr; asm volatile("" : "+v"(row0)); int col0 = u.pn * 256 + wc * 32 + 8 * fq; asm volatile("" : "+v"(col0));
#pragma unroll
        for (int ai = 0; ai < 2; ++ai)
#pragma unroll
            for (int m = 0; m < 4; ++m) { const int row = row0 + ai * HALF + m * 16;
#pragma unroll
                for (int bj = 0; bj < 2; ++bj) { const int col = col0 + bj * HALF; f32x4 v0 = acc[ai][bj][m][0], v1 = acc[ai][bj][m][1];
                    if (u.pn < 4) { *(u32x4*)(upool + (size_t)row * PW + col) = pack8(v0, v1); }
                    else if (u.pn < 8) { const int cs = col - PW, gg = cs >> 4, hh = cs & 15, lc = row >> 5, s = row & 31;
                        *(u32x4*)(X + (size_t)gg * XGS + (size_t)lc * XK + 256 + s * 16 + hh) = pack8(v0, v1); }
                    else {
#pragma unroll
                        for (int j = 0; j < 4; ++j) { v0[j] = silu_f(v0[j]); v1[j] = silu_f(v1[j]); }
                        *(u32x4*)(zs + (size_t)row * D + (col - PW - SW)) = pack8(v0, v1); } } }
    }
};
struct EpiCtx {
    static constexpr bool PERM = true;
    f16* X;
    __device__ __forceinline__ void operator()(AccRef acc, const Unit& u, int wr, int wc, int fr, int fq) const {
        int row0 = u.pm * 256 + wr * 64 + fr; asm volatile("" : "+v"(row0)); int col0 = u.pn * 256 + wc * 32 + 8 * fq; asm volatile("" : "+v"(col0));
#pragma unroll
        for (int ai = 0; ai < 2; ++ai)
#pragma unroll
            for (int m = 0; m < 4; ++m) { const int row = row0 + ai * HALF + m * 16;
#pragma unroll
                for (int bj = 0; bj < 2; ++bj) { const int cs = col0 + bj * HALF, gg = cs >> 4, hh = cs & 15, lc = NLC + (row >> 5), s = row & 31;
                    *(u32x4*)(X + (size_t)gg * XGS + (size_t)lc * XK + 256 + s * 16 + hh) = pack8(acc[ai][bj][m][0], acc[ai][bj][m][1]); } }
    }
};
struct EpiPool {
    static constexpr bool PERM = true;
    f16* branch; const f16* zs; const float* pscale;
    __device__ __forceinline__ void operator()(AccRef acc, const Unit& u, int wr, int wc, int fr, int fq) const {
        int row0 = u.pm * 256 + wr * 64 + fr; asm volatile("" : "+v"(row0)); int col0 = u.g * 256 + wc * 32 + 8 * fq; asm volatile("" : "+v"(col0));
        f32x4 sc[2][2];
#pragma unroll
        for (int bj = 0; bj < 2; ++bj) { sc[bj][0] = *(const f32x4*)(pscale + col0 + bj * HALF); sc[bj][1] = *(const f32x4*)(pscale + col0 + bj * HALF + 4); }
#pragma unroll
        for (int ai = 0; ai < 2; ++ai)
#pragma unroll
          for (int mp = 0; mp < 2; ++mp) { u32x4 zv[2][2];
#pragma unroll
            for (int mm = 0; mm < 2; ++mm)
#pragma unroll
                for (int bj = 0; bj < 2; ++bj) zv[mm][bj] = *(const u32x4*)(zs + (size_t)(row0 + ai * HALF + (mp * 2 + mm) * 16) * D + col0 + bj * HALF);
            __builtin_amdgcn_sched_barrier(0);
#pragma unroll
            for (int mm = 0; mm < 2; ++mm)
#pragma unroll
                for (int bj = 0; bj < 2; ++bj) { const int m = mp * 2 + mm; const size_t o = (size_t)(row0 + ai * HALF + m * 16) * D + col0 + bj * HALF; f32x4 z0, z1; unpack8(zv[mm][bj], z0, z1);
                    *(u32x4*)(branch + o) = pack8(acc[ai][bj][m][0] * sc[bj][0] * z0, acc[ai][bj][m][1] * sc[bj][1] * z1); } }
    }
};
struct EpiS {
    static constexpr bool PERM = false;
    float* S;
    __device__ __forceinline__ void operator()(AccRef acc, const Unit& u, int wr, int wc, int fr, int fq) const {
        int row0 = u.pm * 256 + wr * 64 + fr; asm volatile("" : "+v"(row0)); int col0 = wc * 32 + 4 * fq; asm volatile("" : "+v"(col0));
#pragma unroll
        for (int ai = 0; ai < 2; ++ai)
#pragma unroll
            for (int m = 0; m < 4; ++m) { const int row = row0 + ai * HALF + m * 16;
                if (row < NCH) { float* rp = S + ((size_t)u.g * NCH + row) * 256 + col0;
#pragma unroll
                    for (int bj = 0; bj < 2; ++bj)
#pragma unroll
                        for (int n = 0; n < 2; ++n) *(f32x4*)(rp + bj * HALF + n * 16) = acc[ai][bj][m][n]; } }
    }
};
struct EpiY {
    static constexpr bool PERM = true;
    f16* YG; const f16* X; const float* dskip;
    __device__ __forceinline__ void operator()(AccRef acc, const Unit& u, int wr, int wc, int fr, int fq) const {
        int row0 = u.pm * 256 + wr * 64 + fr; asm volatile("" : "+v"(row0)); int col0 = u.pn * 256 + wc * 32 + 8 * fq; asm volatile("" : "+v"(col0));
        const float* dp = dskip + u.g * GH + (col0 & 15);
        const f32x4 d0 = *(const f32x4*)dp, d1 = *(const f32x4*)(dp + 4);
        const f16* Xg = X + (size_t)u.g * XGS + 256 + col0; f16* Yg = YG + (size_t)u.g * YGS + col0;
#pragma unroll
        for (int ai = 0; ai < 2; ++ai) { u32x4 uv[4][2];
#pragma unroll
            for (int m = 0; m < 4; ++m)
#pragma unroll
                for (int bj = 0; bj < 2; ++bj) uv[m][bj] = *(const u32x4*)(Xg + (size_t)(row0 + ai * HALF + m * 16) * XK + bj * HALF);
            __builtin_amdgcn_sched_barrier(0);
#pragma unroll
            for (int m = 0; m < 4; ++m)
#pragma unroll
                for (int bj = 0; bj < 2; ++bj) { f32x4 u0, u1; unpack8(uv[m][bj], u0, u1);
                    f32x4 v0 = acc[ai][bj][m][0] + d0 * u0, v1 = acc[ai][bj][m][1] + d1 * u1;
#pragma unroll
                    for (int j = 0; j < 4; ++j) { v0[j] = gelu_tanh_f(v0[j]); v1[j] = gelu_tanh_f(v1[j]); }
                    *(u32x4*)(Yg + (size_t)(row0 + ai * HALF + m * 16) * 512 + bj * HALF) = pack8(v0, v1); } }
    }
};
struct EpiGlu {
    static constexpr bool PERM = true;
    f16* branch; const f16* zs; const float* gb;
    __device__ __forceinline__ void operator()(AccRef acc, const Unit& u, int wr, int wc, int fr, int fq) const {
        int row0 = u.pm * 256 + wr * 64 + fr; asm volatile("" : "+v"(row0)); int col0 = u.pn * 128 + wc * 32 + 8 * fq; asm volatile("" : "+v"(col0));
        const f32x4 b10 = *(const f32x4*)(gb + col0), b11 = *(const f32x4*)(gb + col0 + 4), b20 = *(const f32x4*)(gb + SW + col0), b21 = *(const f32x4*)(gb + SW + col0 + 4);
        u32x4 zv[2][4];
#pragma unroll
        for (int ai = 0; ai < 2; ++ai)
#pragma unroll
            for (int m = 0; m < 4; ++m) zv[ai][m] = *(const u32x4*)(zs + (size_t)(row0 + ai * HALF + m * 16) * D + PW + col0);
        __builtin_amdgcn_sched_barrier(0);
#pragma unroll
        for (int ai = 0; ai < 2; ++ai)
#pragma unroll
            for (int m = 0; m < 4; ++m) { const size_t o = (size_t)(row0 + ai * HALF + m * 16) * D + PW + col0;
                f32x4 z0, z1; unpack8(zv[ai][m], z0, z1);
                f32x4 y10 = acc[ai][0][m][0] + b10, y11 = acc[ai][0][m][1] + b11, y20 = acc[ai][1][m][0] + b20, y21 = acc[ai][1][m][1] + b21;
#pragma unroll
                for (int j = 0; j < 4; ++j) { y10[j] = y10[j] * fast_sigmoid(y20[j]) * z0[j]; y11[j] = y11[j] * fast_sigmoid(y21[j]) * z1[j]; }
                *(u32x4*)(branch + o) = pack8(y10, y11); }
    }
};
struct EpiOut {
    static constexpr bool PERM = true;
    const float* x; f16* xo; const float* mod; float* rowss;
    __device__ __forceinline__ void operator()(AccRef acc, const Unit& u, int wr, int wc, int fr, int fq) const {
        int row0 = u.pm * 256 + wr * 64 + fr; asm volatile("" : "+v"(row0)); int col0 = u.pn * 256 + wc * 32 + 8 * fq; asm volatile("" : "+v"(col0));
        const float* gate = mod + (size_t)(u.pm >= 32 ? 1 : 0) * 3 * D + 2 * D + col0;
        f32x4 gv[2][2];
#pragma unroll
        for (int bj = 0; bj < 2; ++bj)
#pragma unroll
            for (int n = 0; n < 2; ++n) gv[bj][n] = *(const f32x4*)(gate + bj * HALF + n * 4);
#pragma unroll
        for (int ai = 0; ai < 2; ++ai)
#pragma unroll
            for (int mp = 0; mp < 2; ++mp) { f32x4 xv[2][2][2];
#pragma unroll
                for (int mm = 0; mm < 2; ++mm)
#pragma unroll
                    for (int bj = 0; bj < 2; ++bj)
#pragma unroll
                        for (int n = 0; n < 2; ++n) xv[mm][bj][n] = ld_nt(x + (size_t)(row0 + ai * HALF + (mp * 2 + mm) * 16) * D + col0 + bj * HALF + n * 4);
                __builtin_amdgcn_sched_barrier(0);
#pragma unroll
                for (int mm = 0; mm < 2; ++mm) { const int m = mp * 2 + mm; const int row = row0 + ai * HALF + m * 16; const size_t o = (size_t)row * D + col0; float ss = 0.f;
#pragma unroll
                    for (int bj = 0; bj < 2; ++bj) { const f32x4 r0 = xv[mm][bj][0] + gv[bj][0] * acc[ai][bj][m][0], r1 = xv[mm][bj][1] + gv[bj][1] * acc[ai][bj][m][1];
                        *(u32x4*)(xo + o + bj * HALF) = pack8h(r0, r1);
                        ss += ((r0[0] * r0[0] + r0[1] * r0[1]) + (r0[2] * r0[2] + r0[3] * r0[3])) + ((r1[0] * r1[0] + r1[1] * r1[1]) + (r1[2] * r1[2] + r1[3] * r1[3])); }
                    ss += __shfl_xor(ss, 16); ss += __shfl_xor(ss, 32);
                    if (fq == 0) rowss[(size_t)row * 32 + u.pn * 4 + wc] = ss; } }
    }
};

constexpr int LDS_BYTES = 147456;

struct Args { const float* in[22]; float* out; unsigned char* ws; int ph_lo, ph_hi; };

constexpr int APS = 132;
constexpr int T_AP = 0, T_QQ = T_AP + 33 * APS, T_BR = T_QQ + 256, T_BI = T_BR + 2048, T_CR = T_BI + 2048, T_CI = T_CR + 2048, T_END = T_CI + 2048;
static_assert(T_END * 4 <= 131072 && (T_BR % 4) == 0 && (T_QQ % 4) == 0, "tables LDS");
__device__ __forceinline__ void ssm_tables(LAS float* L, int item, const float* lam_re, const float* lam_im, const float* log_dt, const float* b_re, const float* b_im,
                                           const float* c_re, const float* c_im, f16* PG, f16* QG, f16* KTH) {
    const int g = item >> 1, dir = item & 1;
    const int tid = threadIdx.x, lane = tid & 63, wave = tid >> 6;
    f16* PGg = PG + (size_t)g * PGS; f16* QGg = QG + (size_t)g * QGS; f16* KTg = KTH + (size_t)g * (63 * 256);
    float cre[4], cim[4], bre[4], bim[4];
#pragma unroll
    for (int q = 0; q < 4; ++q) { const int i = tid + NTHREADS * q; const int d2 = i / 1024, r = i % 1024; const int pg = d2 * NG + g;
        cre[q] = c_re[(size_t)pg * 1024 + r]; cim[q] = c_im[(size_t)pg * 1024 + r]; bre[q] = b_re[(size_t)pg * 1024 + r]; bim[q] = b_im[(size_t)pg * 1024 + r]; }
    { const int n = tid >> 3, seg = tid & 7; const int pg = dir * NG + g;
      const float dt = expf(log_dt[pg]), lr = lam_re[pg * NS + n], li = lam_im[pg * NS + n];
      const float th = li * dt; float sn, cs; sincosf(th, &sn, &cs);
      const float er = expf(lr * dt); const float ar = er * cs, ai = er * sn;
      float pr, pi; { const float eb = expf((float)(4 * seg) * lr * dt); float s4, c4; sincosf((float)(4 * seg) * th, &s4, &c4); pr = eb * c4; pi = eb * s4; }
#pragma unroll
      for (int j = 0; j < 4; ++j) { *(LAS f32x2*)(L + T_AP + (4 * seg + j) * APS + 2 * n) = (f32x2){pr, pi}; const float nr = pr * ar - pi * ai, ni = pr * ai + pi * ar; pr = nr; pi = ni; }
      if (seg == 7) *(LAS f32x2*)(L + T_AP + 32 * APS + 2 * n) = (f32x2){pr, pi}; }
    if (tid < 128) { const int d2 = tid >> 6, n = tid & 63; const int pg = d2 * NG + g;
      const float dt = expf(log_dt[pg]), lr = lam_re[pg * NS + n], li = lam_im[pg * NS + n];
      const float th = li * dt; float sn, cs; sincosf(th, &sn, &cs); const float sh = sinf(0.5f * th);
      const float em1 = expm1f(lr * dt), er = em1 + 1.f;
      const float nr = em1 * cs - 2.f * sh * sh, ni = er * sn, den = lr * lr + li * li;
      *(LAS f32x2*)(L + T_QQ + (d2 * 64 + n) * 2) = (f32x2){(nr * lr + ni * li) / den, (ni * lr - nr * li) / den}; }
#pragma unroll
    for (int q = 0; q < 4; ++q) { const int i = tid + NTHREADS * q; L[T_CR + i] = cre[q]; L[T_CI + i] = cim[q]; }
    __syncthreads();
#pragma unroll
    for (int q = 0; q < 4; ++q) { const int i = tid + NTHREADS * q; const int d2 = i / 1024, n = (i / 16) % 64;
        const f32x2 qq = *(const LAS f32x2*)(L + T_QQ + (d2 * 64 + n) * 2);
        L[T_BR + i] = qq.x * bre[q] - qq.y * bim[q]; L[T_BI + i] = qq.x * bim[q] + qq.y * bre[q]; }
    __syncthreads();
    { const int fr = lane & 15, fq = lane >> 4;
      auto bfrag = [&](int d2, int kk) { f16x8 v;
#pragma unroll
          for (int e2 = 0; e2 < 4; ++e2) { const int n = 16 * kk + 4 * fq + e2; v[2 * e2] = (f16)L[T_BR + d2 * 1024 + n * 16 + fr]; v[2 * e2 + 1] = (f16)L[T_BI + d2 * 1024 + n * 16 + fr]; }
          return v; };
      auto afrag = [&](int d2, int kk, int j, bool unit) { f16x8 v;
#pragma unroll
          for (int e2 = 0; e2 < 4; ++e2) { const int n = 16 * kk + 4 * fq + e2; const float cr = L[T_CR + d2 * 1024 + fr * 64 + n], ci = L[T_CI + d2 * 1024 + fr * 64 + n];
              f32x2 p = {1.f, 0.f}; if (!unit) p = *(const LAS f32x2*)(L + T_AP + j * APS + 2 * n);
              v[2 * e2] = (f16)(cr * p.x - ci * p.y); v[2 * e2 + 1] = (f16)(-(cr * p.y + ci * p.x)); }
          return v; };
      f16x8 bf[4];
#pragma unroll
      for (int kk = 0; kk < 4; ++kk) bf[kk] = bfrag(dir, kk);
#pragma unroll 1
      for (int jj = 0; jj < 4; ++jj) { const int j = 4 * wave + jj;
          if (j == 0 && dir == 1) continue;
          f32x4 d = {0.f, 0.f, 0.f, 0.f};
#pragma unroll
          for (int kk = 0; kk < 4; ++kk) d = MFMA16(afrag(dir, kk, j, false), bf[kk], d);
          if (j == 0) {
#pragma unroll
              for (int kk = 0; kk < 4; ++kk) d = MFMA16(afrag(1, kk, 0, true), bfrag(1, kk), d); }
          const int li = dir == 0 ? 31 + j : 31 - j;
#pragma unroll
          for (int r = 0; r < 4; ++r) KTg[li * 256 + (4 * fq + r) * 16 + fr] = (f16)d[r]; } }
    { const int sp = lane >> 1, h0 = (lane & 1) * 8; const int e = dir == 0 ? TC - 1 - sp : sp;
      for (int jr = wave; jr < 128; jr += NWAVES) { const int ri = jr >> 6, n = jr & 63;
        const f32x2 p = *(const LAS f32x2*)(L + T_AP + e * APS + 2 * n);
        const LAS f32x4* brp = (const LAS f32x4*)(L + T_BR + dir * 1024 + n * 16 + h0); const LAS f32x4* bip = (const LAS f32x4*)(L + T_BI + dir * 1024 + n * 16 + h0);
        const f32x4 br0 = brp[0], br1 = brp[1], bi0 = bip[0], bi1 = bip[1];
        const f32x4 v0 = ri == 0 ? p.x * br0 - p.y * bi0 : p.x * bi0 + p.y * br0, v1 = ri == 0 ? p.x * br1 - p.y * bi1 : p.x * bi1 + p.y * br1;
        *(u32x4*)(PGg + (size_t)(dir * 128 + jr) * 512 + lane * 8) = pack8(v0, v1); } }
    { const int k0 = (lane & 15) * 8, ri = k0 >> 6, n0 = k0 & 63;
      for (int it = 0; it < 16; ++it) { const int nrow = wave * 64 + it * 4 + (lane >> 4), s = nrow >> 4, h = nrow & 15; const int e = dir == 0 ? s + 1 : TC - s;
        const LAS f32x4* crp = (const LAS f32x4*)(L + T_CR + dir * 1024 + h * 64 + n0); const LAS f32x4* cip = (const LAS f32x4*)(L + T_CI + dir * 1024 + h * 64 + n0);
        const LAS f32x4* app = (const LAS f32x4*)(L + T_AP + e * APS + 2 * n0);
        const f32x4 cr0 = crp[0], cr1 = crp[1], ci0 = cip[0], ci1 = cip[1], a0 = app[0], a1 = app[1], a2 = app[2], a3 = app[3];
        const f32x4 pr0 = {a0[0], a0[2], a1[0], a1[2]}, pi0 = {a0[1], a0[3], a1[1], a1[3]}, pr1 = {a2[0], a2[2], a3[0], a3[2]}, pi1 = {a2[1], a2[3], a3[1], a3[3]};
        const f32x4 v0 = ri == 0 ? cr0 * pr0 - ci0 * pi0 : -(cr0 * pi0 + ci0 * pr0), v1 = ri == 0 ? cr1 * pr1 - ci1 * pi1 : -(cr1 * pi1 + ci1 * pr1);
        *(u32x4*)(QGg + (size_t)nrow * 256 + dir * 128 + k0) = pack8(v0, v1); } }
    __syncthreads();
}
__device__ __forceinline__ void ssm_scan(LAS float* L, int item, const float* lam_re, const float* lam_im, const float* log_dt, const float* S, f16* X) {
    const int b = item >> 7, dir = (item >> 6) & 1, g = item & 63;
    const int tid = threadIdx.x, seg = tid >> 6, n = tid & 63, pg = dir * NG + g;
    const float dt = expf(log_dt[pg]), lr = lam_re[pg * NS + n], li = lam_im[pg * NS + n];
    float tr, ti, sr, si;
    { const float er = expf((float)TC * lr * dt); float sn, cs; sincosf((float)TC * (li * dt), &sn, &cs); tr = er * cs; ti = er * sn; }
    { const float er = expf((float)(33 * TC) * lr * dt); float sn, cs; sincosf((float)(33 * TC) * (li * dt), &sn, &cs); sr = er * cs; si = er * sn; }
    const float* Sg = S + (size_t)g * NCH * 256 + dir * 128 + n;
    f16* Xg = X + (size_t)g * XGS + dir * 128 + n;
    float vr[33], vi[33];
#pragma unroll
    for (int i = 0; i < 33; ++i) { const int p = seg * 33 + i;
        const int row = p < 8 ? NLC + b * 8 + (dir == 0 ? p : 7 - p) : b * 256 + (dir == 0 ? p - 8 : 255 - (p - 8));
        vr[i] = Sg[(size_t)row * 256]; vi[i] = Sg[(size_t)row * 256 + 64]; }
    __builtin_amdgcn_sched_barrier(0);
    float hr = 0.f, hi = 0.f;
#pragma unroll
    for (int i = 0; i < 33; ++i) { const float s_r = vr[i], s_i = vi[i]; vr[i] = hr; vi[i] = hi; const float nr = tr * hr - ti * hi + s_r, ni = tr * hi + ti * hr + s_i; hr = nr; hi = ni; }
    L[(seg * 64 + n) * 2] = hr; L[(seg * 64 + n) * 2 + 1] = hi;
    __syncthreads();
    float ir = 0.f, ii = 0.f;
    for (int k = 0; k < seg; ++k) { const float er = L[(k * 64 + n) * 2], ei = L[(k * 64 + n) * 2 + 1]; const float nr = sr * ir - si * ii + er, ni = sr * ii + si * ir + ei; ir = nr; ii = ni; }
    float pr = 1.f, pi = 0.f;
#pragma unroll
    for (int i = 0; i < 33; ++i) { const int p = seg * 33 + i;
        const float fr_ = vr[i] + pr * ir - pi * ii, fi_ = vi[i] + pr * ii + pi * ir;
        if (p >= 8) { const int row = b * 256 + (dir == 0 ? p - 8 : 255 - (p - 8)); Xg[(size_t)row * XK] = (f16)fr_; Xg[(size_t)row * XK + 64] = (f16)fi_; }
        const float npr = pr * tr - pi * ti, npi = pr * ti + pi * tr; pr = npr; pi = npi; }
    __syncthreads();
}

#define XB_TMO      128
#define XB_XCNT(j)  (256  + 64 * (j))
#define XB_XSUB(j)  (1280 + 64 * (j))
#define XB_XGEN(j)  (2304 + 64 * (j))
#define XB_TOP      3328
#define XB_TOPGEN   3392
#define XCD_BAR_WORDS 3456
#define XB_SPIN_CAP (1u << 18)
__device__ __forceinline__ unsigned xb_ld(unsigned* p)              { return __hip_atomic_load(p, __ATOMIC_RELAXED, __HIP_MEMORY_SCOPE_AGENT); }
__device__ __forceinline__ unsigned xb_add(unsigned* p, unsigned v) { return __hip_atomic_fetch_add(p, v, __ATOMIC_RELAXED, __HIP_MEMORY_SCOPE_AGENT); }
__device__ __forceinline__ unsigned xb_xcc_id() { return (unsigned)__builtin_amdgcn_s_getreg((3 << 11) | 20) & 0xFu; }
#define XB_SPIN(cond, bar) do { unsigned _sp = 0; while (cond) { __builtin_amdgcn_s_sleep(1); \
    if ((++_sp & 255u) == 0u) { if (xb_ld(&(bar)[XB_TMO])) break; if (_sp > XB_SPIN_CAP) { atomicAdd(&(bar)[XB_TMO], 1u); break; } } } } while (0)
struct XcdBarrier { unsigned* bar; unsigned x; volatile LAS unsigned* st; };
__device__ __forceinline__ XcdBarrier xcd_barrier_post(unsigned* bar, volatile LAS unsigned* st) {
    XcdBarrier b; b.bar = bar; b.x = xb_xcc_id(); b.st = st;
    if (threadIdx.x == 0) (void)xb_add(&bar[XB_XCNT(b.x)], 1u);
    return b;
}
__device__ __forceinline__ void xcd_barrier_complete(unsigned* bar, unsigned x, unsigned& nloc, unsigned& nx) {
    const unsigned G = gridDim.x * gridDim.y * gridDim.z;
    unsigned sum, cnt, mine, sp = 0u;
    for (;;) {
        sum = 0u; cnt = 0u; mine = 0u;
#pragma unroll
        for (unsigned j = 0; j < 16; ++j) { const unsigned c = xb_ld(&bar[XB_XCNT(j)]); sum += c; cnt += (c > 0u) ? 1u : 0u; mine = (j == x) ? c : mine; }
        if (sum == G) break;
        __builtin_amdgcn_s_sleep(1);
        if ((++sp & 255u) == 0u) { if (xb_ld(&bar[XB_TMO])) break; if (sp > XB_SPIN_CAP) { atomicAdd(&bar[XB_TMO], 1u); break; } }
    }
    nloc = mine > 0u ? mine : 1u; nx = cnt > 0u ? cnt : 1u;
}
__device__ __forceinline__ void xcd_barrier(const XcdBarrier& b) {
    asm volatile("s_waitcnt vmcnt(0)" ::: "memory");
    __syncthreads();
    if (threadIdx.x == 0) {
        unsigned* bar = b.bar;
        __builtin_amdgcn_s_waitcnt(0);
        unsigned nloc = b.st[0], nx = b.st[1];
        if (nloc == 0u) { xcd_barrier_complete(bar, b.x, nloc, nx); b.st[0] = nloc; b.st[1] = nx; }
        const unsigned old = xb_add(&bar[XB_XSUB(b.x)], 1u);
        const unsigned gen = old / nloc;
        if (old + 1u == (gen + 1u) * nloc) {
            __builtin_amdgcn_fence(__ATOMIC_RELEASE, "agent");
            asm volatile("s_waitcnt vmcnt(0)" ::: "memory");
            const unsigned og = xb_add(&bar[XB_TOP], 1u);
            const unsigned tg = og / nx;
            if (og + 1u == (tg + 1u) * nx) xb_add(&bar[XB_TOPGEN], 1u);
            else XB_SPIN(xb_ld(&bar[XB_TOPGEN]) == tg, bar);
            __builtin_amdgcn_fence(__ATOMIC_ACQUIRE, "agent");
            xb_add(&bar[XB_XGEN(b.x)], 1u);
            asm volatile("s_waitcnt vmcnt(0)" ::: "memory");
        } else {
            XB_SPIN(xb_ld(&bar[XB_XGEN(b.x)]) == gen, bar);
            __builtin_amdgcn_fence(__ATOMIC_ACQUIRE, "agent");
            asm volatile("s_waitcnt vmcnt(0)" ::: "memory");
        }
    }
    __syncthreads();
}
__device__ __forceinline__ int q_pop(unsigned* q, volatile LAS int* slot) {
    __syncthreads();
    if (threadIdx.x == 0) *slot = (int)__hip_atomic_fetch_add(q, 1u, __ATOMIC_RELAXED, __HIP_MEMORY_SCOPE_AGENT);
    __syncthreads();
    return *slot;
}
__device__ __forceinline__ float wave_sum(float v) {
#pragma unroll
    for (int o = 1; o < 64; o <<= 1) v += __shfl_xor(v, o);
    return v;
}

__device__ __forceinline__ void gemv_item(LAS float* L, int item, const float* c, const float* c_ctx, const float* ada_w, const float* ada_b, float* mod) {
    const int tid = threadIdx.x, wave = tid >> 6;
    for (int i = tid; i < 3 * D; i += NTHREADS) { const int r = i / D, k = i % D; const float v = r < 2 ? c[r * D + k] : c_ctx[k]; L[i] = v / (1.f + expf(-v)); }
    __syncthreads();
    const int l8 = tid & 7, rs = tid >> 3, n0 = item * 32;
    const float* wp = ada_w + n0 + 4 * l8;
    f32x4 a0 = {0.f, 0.f, 0.f, 0.f}, a1 = a0, a2 = a0;
    f32x4 wv[32];
#pragma unroll
    for (int i = 0; i < 32; ++i) wv[i] = ld_nt(wp + (size_t)(rs + 64 * i) * (3 * D));
    __builtin_amdgcn_sched_barrier(0);
#pragma unroll
    for (int i = 0; i < 32; ++i) { const int k = rs + 64 * i; a0 += L[k] * wv[i]; a1 += L[D + k] * wv[i]; a2 += L[2 * D + k] * wv[i]; }
#pragma unroll
    for (int e = 0; e < 4; ++e) {
#pragma unroll
        for (int o = 8; o < 64; o <<= 1) { a0[e] += __shfl_xor(a0[e], o); a1[e] += __shfl_xor(a1[e], o); a2[e] += __shfl_xor(a2[e], o); } }
    LAS float* red = L + 3 * D;
    if ((tid & 63) < 8) {
#pragma unroll
        for (int e = 0; e < 4; ++e) { red[wave * 96 + l8 * 4 + e] = a0[e]; red[wave * 96 + 32 + l8 * 4 + e] = a1[e]; red[wave * 96 + 64 + l8 * 4 + e] = a2[e]; } }
    __syncthreads();
    if (tid < 96) { float sum = 0.f;
#pragma unroll
        for (int w = 0; w < 8; ++w) sum += red[w * 96 + tid];
        const int r = tid >> 5, col = tid & 31; mod[r * 3 * D + n0 + col] = sum + ada_b[n0 + col]; }
    __syncthreads();
}
__device__ __forceinline__ void transpose_item(const float* W, int K, int N, f16* WT, LAS float* scr, int item, int lane) {
    const int nblk = N / 32, kb = item / nblk, nb = item % nblk, k0 = 64 * kb, n0 = 32 * nb;
    const int kr = lane >> 3, nq = (lane & 7) * 4;
    f32x4 v[8];
#pragma unroll
    for (int i = 0; i < 8; ++i) v[i] = ld_nt(W + (size_t)(k0 + kr + 8 * i) * N + n0 + nq);
    __builtin_amdgcn_sched_barrier(0);
#pragma unroll
    for (int i = 0; i < 8; ++i) { LAS float* sp = scr + (kr + 8 * i) * 33 + nq; sp[0] = v[i][0]; sp[1] = v[i][1]; sp[2] = v[i][2]; sp[3] = v[i][3]; }
    asm volatile("s_waitcnt lgkmcnt(0)" ::: "memory");
    const int c = lane & 7;
#pragma unroll
    for (int j = 0; j < 4; ++j) { const int n = (lane >> 3) + 8 * j; const LAS float* sp = scr + (8 * c) * 33 + n;
        u32x4 o; o.x = pk_f16(sp[0 * 33], sp[1 * 33]); o.y = pk_f16(sp[2 * 33], sp[3 * 33]); o.z = pk_f16(sp[4 * 33], sp[5 * 33]); o.w = pk_f16(sp[6 * 33], sp[7 * 33]);
        *(u32x4*)(WT + (size_t)(n0 + n) * K + k0 + 8 * c) = o; }
    asm volatile("s_waitcnt lgkmcnt(0)" ::: "memory");
}
constexpr int TI_IN = (D / 64) * (4096 / 32), TI_OUT = (D / 64) * (D / 32), TI_GLU = (SW / 64) * (2 * SW / 32), TI_POOL1 = (256 / 64) * (256 / 32), TI_ALL = TI_IN + TI_OUT + TI_GLU + 4 * TI_POOL1;
__device__ __forceinline__ void transpose_dispatch(int it, const float* in_w, const float* out_w, const float* glu_w, const float* pool_w, unsigned char* ws, LAS float* scr, int lane) {
    if (it < TI_IN) { transpose_item(in_w, D, 4096, (f16*)(ws + WS_WIN), scr, it, lane); return; } it -= TI_IN;
    if (it < TI_OUT) { transpose_item(out_w, D, D, (f16*)(ws + WS_WOUT), scr, it, lane); return; } it -= TI_OUT;
    if (it < TI_GLU) { transpose_item(glu_w, SW, 2 * SW, (f16*)(ws + WS_WGLU), scr, it, lane); return; } it -= TI_GLU;
    const int pg = it / TI_POOL1; transpose_item(pool_w + pg * 65536, 256, 256, (f16*)(ws + WS_WPOOL) + pg * 65536, scr, it % TI_POOL1, lane);
}
__device__ __forceinline__ void norm_rows(int gw, int lane, const float* x, const float* ctx, const float* ng, const float* mod, f16* h) {
    f32x4 gs[8], sh[8];
    auto load_mod = [&](int mr) { const float* shp = mod + mr * 3 * D;
#pragma unroll
        for (int j = 0; j < 8; ++j) { const int cidx = 256 * j + 4 * lane; const f32x4 g4 = *(const f32x4*)(ng + cidx), s4 = *(const f32x4*)(shp + D + cidx); gs[j] = g4 * (1.f + s4); sh[j] = *(const f32x4*)(shp + cidx); } };
    auto finish_row = [&](const f32x4 (&v)[8], f16* dst) { float ss = 0.f;
#pragma unroll
        for (int j = 0; j < 8; ++j) ss += (v[j][0] * v[j][0] + v[j][1] * v[j][1]) + (v[j][2] * v[j][2] + v[j][3] * v[j][3]);
        const float rstd = rsqrtf(wave_sum(ss) * (1.f / D) + EPS);
#pragma unroll
        for (int j = 0; j < 8; ++j) { const f32x4 o = v[j] * rstd * gs[j] + sh[j]; u32x2 w; w.x = pk_f16(o[0], o[1]); w.y = pk_f16(o[2], o[3]); *(u32x2*)(dst + 256 * j + 4 * lane) = w; } };
    constexpr int RPW = 8;
    const int r0 = gw * RPW;
    if (r0 < M_LAT) { load_mod(r0 / SEQ);
#pragma unroll 1
        for (int rb = r0; rb < r0 + RPW; rb += 4) { f32x4 v[4][8];
#pragma unroll
            for (int rr = 0; rr < 4; ++rr)
#pragma unroll
                for (int j = 0; j < 8; ++j) v[rr][j] = ld_nt(x + (size_t)(rb + rr) * D + 256 * j + 4 * lane);
            __builtin_amdgcn_sched_barrier(0);
#pragma unroll
            for (int rr = 0; rr < 4; ++rr) finish_row(v[rr], h + (size_t)(rb + rr) * D); } }
    if (gw < M_CTX) { load_mod(2); f32x4 v[8];
#pragma unroll
        for (int j = 0; j < 8; ++j) v[j] = ld_nt(ctx + (size_t)gw * D + 256 * j + 4 * lane);
        finish_row(v, h + (size_t)(M_LAT + gw) * D); }
}
typedef float f32x16 __attribute__((ext_vector_type(16)));
__device__ __forceinline__ void ctx_item(LAS float* L, int item, const f16* hc, const f16* Wssm, f16* X) {
    const int tid = threadIdx.x, wave = tid >> 6, lane = tid & 63, rb = item >> 4, cb = item & 15, k0 = wave * 256 + 8 * (lane >> 5);
    const f16* ap = hc + (size_t)(rb * 32 + (lane & 31)) * D + k0;
    const f16* bp0 = Wssm + (size_t)(cb * 64 + (lane & 31)) * D + k0; const f16* bp1 = bp0 + (size_t)32 * D;
    f32x16 acc0, acc1;
#pragma unroll
    for (int i = 0; i < 16; ++i) { acc0[i] = 0.f; acc1[i] = 0.f; }
#pragma unroll 1
    for (int kb = 0; kb < 16; kb += 8) { f16x8 av[8], b0[8], b1[8];
#pragma unroll
        for (int k = 0; k < 8; ++k) { av[k] = *(const f16x8*)(ap + (kb + k) * 16); b0[k] = *(const f16x8*)(bp0 + (kb + k) * 16); b1[k] = *(const f16x8*)(bp1 + (kb + k) * 16); }
        __builtin_amdgcn_sched_barrier(0);
#pragma unroll
        for (int k = 0; k < 8; ++k) { acc0 = MFMA32(av[k], b0[k], acc0); acc1 = MFMA32(av[k], b1[k], acc1); } }
#pragma unroll
    for (int r = 0; r < 16; ++r) { L[((wave * 2 + 0) * 16 + r) * 64 + lane] = acc0[r]; L[((wave * 2 + 1) * 16 + r) * 64 + lane] = acc1[r]; }
    __syncthreads();
#pragma unroll
    for (int i = 0; i < 4; ++i) { const int idx = tid + NTHREADS * i, ln = idx & 63, reg = (idx >> 6) & 15, t = idx >> 10; float sum = 0.f;
#pragma unroll
        for (int w = 0; w < 8; ++w) sum += L[((w * 2 + t) * 16 + reg) * 64 + ln];
        const int row = (reg & 3) + 8 * (reg >> 2) + 4 * (ln >> 5), ch = cb * 64 + t * 32 + (ln & 31);
        X[(size_t)(ch >> 4) * XGS + (size_t)(NLC + rb) * XK + 256 + row * 16 + (ch & 15)] = (f16)sum; }
    __syncthreads();
}
__device__ __forceinline__ void ctxs_item(int g, const f16* X, const f16* PG, float* S) {
    const int tid = threadIdx.x, wave = tid >> 6, lane = tid & 63, fr = lane & 15, fq = lane >> 4;
    const f16* ap = X + (size_t)g * XGS + (size_t)(NLC + fr) * XK + 256 + 8 * fq;
    const f16* bp = PG + (size_t)g * PGS + (size_t)(32 * wave + fr) * 512 + 8 * fq;
    f32x4 d0 = {0.f, 0.f, 0.f, 0.f}, d1 = d0;
#pragma unroll 1
    for (int kb = 0; kb < 16; kb += 8) { f16x8 av[8], b0[8], b1[8];
#pragma unroll
        for (int k = 0; k < 8; ++k) { av[k] = *(const f16x8*)(ap + (kb + k) * 32); b0[k] = *(const f16x8*)(bp + (kb + k) * 32); b1[k] = *(const f16x8*)(bp + 16 * 512 + (kb + k) * 32); }
        __builtin_amdgcn_sched_barrier(0);
#pragma unroll
        for (int k = 0; k < 8; ++k) { d0 = MFMA16(av[k], b0[k], d0); d1 = MFMA16(av[k], b1[k], d1); } }
    float* sp = S + ((size_t)g * NCH + NLC + 4 * fq) * 256 + 32 * wave + fr;
#pragma unroll
    for (int r = 0; r < 4; ++r) { sp[(size_t)r * 256] = d0[r]; sp[(size_t)r * 256 + 16] = d1[r]; }
}
__device__ __forceinline__ void pm_item(LAS float* Vs, int item, const f16* up, f16* pm) {
    const int tid = threadIdx.x, b = item >> 7, g = (item >> 5) & 3, band = item & 31, r0 = band * 4;
    const int w = 2 << g, lo_off = w >> 1, hi_off = w - lo_off;
    const int o = tid & 31, cs = tid >> 5;
    const size_t cbase = (size_t)b * SEQ * PW + g * 256 + o * 8;
    float rs[4][8];
#pragma unroll
    for (int q = 0; q < 4; ++q)
#pragma unroll
        for (int e = 0; e < 8; ++e) rs[q][e] = 0.f;
    int cur_lo = r0 - lo_off < 0 ? 0 : r0 - lo_off, cur_hi = cur_lo;
    for (int r = r0; r < r0 + 4; ++r) {
        const int rlo = r - lo_off < 0 ? 0 : r - lo_off, rhi = r + hi_off > ROWS ? ROWS : r + hi_off;
        u32x4 cen[4];
#pragma unroll
        for (int q = 0; q < 4; ++q) cen[q] = *(const u32x4*)(up + cbase + (size_t)(r * GW + cs + 16 * q) * PW);
        while (cur_hi < rhi) { const int nb = rhi - cur_hi < 4 ? rhi - cur_hi : 4; u32x4 t[4][4];
#pragma unroll
            for (int j = 0; j < 4; ++j) if (j < nb) {
#pragma unroll
                for (int q = 0; q < 4; ++q) t[j][q] = *(const u32x4*)(up + cbase + (size_t)((cur_hi + j) * GW + cs + 16 * q) * PW); }
            __builtin_amdgcn_sched_barrier(0);
#pragma unroll
            for (int j = 0; j < 4; ++j) if (j < nb) {
#pragma unroll
                for (int q = 0; q < 4; ++q) { f32x4 v0, v1; unpack8(t[j][q], v0, v1);
#pragma unroll
                    for (int e = 0; e < 4; ++e) { rs[q][e] += v0[e]; rs[q][4 + e] += v1[e]; } } }
            cur_hi += nb; }
        for (; cur_lo < rlo; ++cur_lo) {
#pragma unroll
            for (int q = 0; q < 4; ++q) { f32x4 v0, v1; unpack8(*(const u32x4*)(up + cbase + (size_t)(cur_lo * GW + cs + 16 * q) * PW), v0, v1);
#pragma unroll
                for (int e = 0; e < 4; ++e) { rs[q][e] -= v0[e]; rs[q][4 + e] -= v1[e]; } } }
        const float inv = 1.f / (float)(rhi - rlo);
#pragma unroll
        for (int q = 0; q < 4; ++q) { LAS f32x4* vp = (LAS f32x4*)(Vs + (cs + 16 * q) * 256 + o * 8);
            vp[0] = (f32x4){rs[q][0] * inv, rs[q][1] * inv, rs[q][2] * inv, rs[q][3] * inv}; vp[1] = (f32x4){rs[q][4] * inv, rs[q][5] * inv, rs[q][6] * inv, rs[q][7] * inv}; }
        __syncthreads();
#pragma unroll
        for (int q = 0; q < 4; ++q) { const int cc = cs + 16 * q; const int clo = cc - lo_off < 0 ? 0 : cc - lo_off, chi = cc + hi_off > GW ? GW : cc + hi_off;
            f32x4 s0 = {0.f, 0.f, 0.f, 0.f}, s1 = s0;
            for (int c2 = clo; c2 < chi; ++c2) { const LAS f32x4* vp = (const LAS f32x4*)(Vs + c2 * 256 + o * 8); s0 += vp[0]; s1 += vp[1]; }
            const float ic = 1.f / (float)(chi - clo);
            f32x4 u0, u1; unpack8(cen[q], u0, u1);
            *(u32x4*)(pm + cbase + (size_t)(r * GW + cc) * PW) = pack8(s0 * ic - u0, s1 * ic - u1); }
        __syncthreads();
    }
}
__device__ __forceinline__ void final_rows(int gw, int lane, const f16* xo, float* out, const float* fg, const float* rowss) {
    f32x4 g4[4][2];
#pragma unroll
    for (int j = 0; j < 4; ++j) { g4[j][0] = *(const f32x4*)(fg + 512 * j + 8 * lane); g4[j][1] = *(const f32x4*)(fg + 512 * j + 8 * lane + 4); }
#pragma unroll 1
    for (int r0 = gw * 8; r0 < gw * 8 + 8; r0 += 4) {
        u32x4 v[4][4]; float part[4];
#pragma unroll
        for (int rr = 0; rr < 4; ++rr) { part[rr] = lane < 32 ? rowss[(size_t)(r0 + rr) * 32 + lane] : 0.f;
#pragma unroll
            for (int j = 0; j < 4; ++j) v[rr][j] = *(const u32x4*)(xo + (size_t)(r0 + rr) * D + 512 * j + 8 * lane); }
        __builtin_amdgcn_sched_barrier(0);
#pragma unroll
        for (int rr = 0; rr < 4; ++rr) { const float rstd = rsqrtf(wave_sum(part[rr]) * (1.f / D) + EPS); float* rp = out + (size_t)(r0 + rr) * D + 8 * lane;
#pragma unroll
            for (int j = 0; j < 4; ++j) { f32x4 a0, a1; unpack8h(v[rr][j], a0, a1); *(f32x4*)(rp + 512 * j) = a0 * rstd * g4[j][0]; *(f32x4*)(rp + 512 * j + 4) = a1 * rstd * g4[j][1]; } }
    }
}

typedef pg8::Cfg<D / 64, 0, D * 2, (size_t)256 * D * 2, (size_t)128 * D * 2, 128, 0, D * 2, (size_t)256 * D * 2, (size_t)128 * D * 2, 128, 0> CfgDense2048;
typedef pg8::Cfg<512 / 64, 0, XK * 2, (size_t)256 * XK * 2, (size_t)128 * XK * 2, 128, XGS * 2, 512 * 2, 0, (size_t)128 * 512 * 2, 128, PGS * 2> CfgS;
typedef pg8::Cfg<256 / 64, 0, PW * 2, (size_t)256 * PW * 2, (size_t)128 * PW * 2, 128, 512, 256 * 2, 0, (size_t)128 * 256 * 2, 128, (size_t)65536 * 2> CfgPool;
typedef pg8::Cfg<XK / 64, 0, XK * 2, (size_t)256 * XK * 2, (size_t)128 * XK * 2, 128, XGS * 2, 512, (size_t)256 * 512, (size_t)128 * 512, 128, QGS * 2, 1> CfgY;
typedef pg8::Cfg<SW / 64, 1, (unsigned)(YGS * 2), (size_t)256 * 32, (size_t)128 * 32, 4 * YGS * 2, 0, SW * 2, (size_t)128 * SW * 2, (size_t)1024 * SW * 2, 128, 0> CfgGlu;

constexpr int CW_BAR = 0, CW_Q0 = 4096, CW_Q3 = 4096 + 64;
constexpr size_t CTL_ZERO_BYTES = 65536;
constexpr int MISC_OFF = 143360;

__global__ void __launch_bounds__(NTHREADS, 2) mk_fwd(Args a) {
    extern __shared__ __attribute__((aligned(16))) unsigned char lds_raw[];
    LAS unsigned char* lds = (LAS unsigned char*)lds_raw;
    volatile LAS unsigned* MISC = (volatile LAS unsigned*)(lds + MISC_OFF);
    const int G = gridDim.x, bx = blockIdx.x, tid = threadIdx.x, lane = tid & 63, wave = __builtin_amdgcn_readfirstlane(tid >> 6);
    const int vcu = (G % 8 == 0) ? (bx % 8) * (G / 8) + bx / 8 : bx;
    const int lo = a.ph_lo, hi = a.ph_hi;
    unsigned* ctl = (unsigned*)(a.ws + WS_CTL);
    if (tid < 16) MISC[tid] = 0u;
    __syncthreads();
    XcdBarrier bar = xcd_barrier_post(ctl + CW_BAR, MISC);
#define IN(k) (lo <= (k) && (k) < hi)
#define SEAM(k) do { if (IN(k) && IN((k) + 1)) xcd_barrier(bar); } while (0)
#define PHASE(k, ...) do { if (PROBE_PH == (k) && PROBE_SUB < 0) tp0 = __builtin_amdgcn_s_memrealtime(); if (IN(k)) { constexpr int rep = 0; constexpr int phk = (k); (void)rep; (void)phk; __VA_ARGS__ } \
    if (REPEAT_PH == (k) && IN(k)) { xcd_barrier(bar); constexpr int rep = 1; constexpr int phk = (k); (void)rep; (void)phk; __VA_ARGS__ } if (PROBE_PH == (k) && PROBE_SUB == 9) tp0 = __builtin_amdgcn_s_memrealtime(); SEAM(k); if (PROBE_PH == (k) && PROBE_SUB == 9) tp1 = __builtin_amdgcn_s_memrealtime(); if (PROBE_PH == (k) && PROBE_SUB < 0) tp1 = __builtin_amdgcn_s_memrealtime(); } while (0)
#define SUB(i, ...) do { if (PROBE_PH == phk && PROBE_SUB == (i)) { __syncthreads(); tp0 = __builtin_amdgcn_s_memrealtime(); } __VA_ARGS__ if (PROBE_PH == phk && PROBE_SUB == (i)) { asm volatile("s_waitcnt vmcnt(0)" ::: "memory"); __syncthreads(); tp1 = __builtin_amdgcn_s_memrealtime(); } } while (0)
    unsigned long long tp0 = 0, tp1 = 0;
    if (PROBE_PH == 99) tp0 = __builtin_amdgcn_s_memrealtime();
    PHASE(0,
        int tcount; int tstart;
        if (bx < 128) { tcount = 3; tstart = 3 * bx; } else if (bx < 192) { tcount = 1; tstart = 384 + (bx - 128); } else { tcount = 7; tstart = 448 + 7 * (bx - 192); }
        SUB(0, if (bx < 128) ssm_tables((LAS float*)lds, bx, a.in[10], a.in[11], a.in[12], a.in[13], a.in[14], a.in[15], a.in[16], (f16*)(a.ws + WS_PG), (f16*)(a.ws + WS_QG), (f16*)(a.ws + WS_KTH));
               else { gemv_item((LAS float*)lds, bx - 128, a.in[1], a.in[3], a.in[4], a.in[5], (float*)(a.ws + WS_MOD));
                      if (bx < 192) gemv_item((LAS float*)lds, bx, a.in[1], a.in[3], a.in[4], a.in[5], (float*)(a.ws + WS_MOD)); } );
        LAS float* scr = (LAS float*)lds + wave * (64 * 33);
        SUB(1, for (int it = tstart; it < tstart + tcount; ++it) transpose_dispatch(it * 8 + wave, a.in[7], a.in[20], a.in[18], a.in[8], a.ws, scr, lane);
               if (bx >= 240) transpose_dispatch((896 + bx - 240) * 8 + wave, a.in[7], a.in[20], a.in[18], a.in[8], a.ws, scr, lane); );
    );
    PHASE(1, norm_rows(vcu * NWAVES + wave, lane, a.in[0], a.in[2], a.in[6], (const float*)(a.ws + WS_MOD), (f16*)(a.ws + WS_H)); );
    PHASE(2,
        pg8::DenseOrder S; S.init(M_LAT / 256, 4096 / 256, G, bx, WGM_IN);
        EpiInProj E{(f16*)(a.ws + WS_UPOOL), (f16*)(a.ws + WS_X), (f16*)(a.ws + WS_ZS)};
        SUB(0, pg8::gemm_phase<CfgDense2048, EpiInProj, pg8::DenseOrder, true, true>(lds, (const char*)(a.ws + WS_H), (const char*)(a.ws + WS_WIN), S, E); );
        for (int it = bx; it < 256; it += G) ctx_item((LAS float*)lds, it, (const f16*)(a.ws + WS_H) + (size_t)M_LAT * D, (const f16*)(a.ws + WS_WIN) + (size_t)PW * D, (f16*)(a.ws + WS_X));
    );
    PHASE(3,
        { pg8::ListOrder S; S.init(NG * 2, 2, 1, G, vcu);
          EpiS E{(float*)(a.ws + WS_S)};
          SUB(0, pg8::gemm_phase<CfgS, EpiS, pg8::ListOrder, true, true>(lds, (const char*)(a.ws + WS_X + 512), (const char*)(a.ws + WS_PG), S, E);
                 if (vcu >= 128 && vcu < 192) ctxs_item(vcu - 128, (const f16*)(a.ws + WS_X), (const f16*)(a.ws + WS_PG), (float*)(a.ws + WS_S)); ); }
        { const int v = vcu & 255; const int pgp = v < 128 ? (v >> 6) : 2 + ((v - 128) >> 6), rest = v & 63, pb = rest >> 5, band = rest & 31;
            SUB(1, pm_item((LAS float*)lds, (pb << 7) | (pgp << 5) | band, (const f16*)(a.ws + WS_UPOOL), (f16*)(a.ws + WS_PM)); );
            asm volatile("s_waitcnt vmcnt(0)" ::: "memory"); __syncthreads();
            pg8::OneUnit S1; S1.u.g = pgp; S1.u.pm = pb * 32 + band; S1.u.pn = 0; S1.have = true;
            EpiPool E{(f16*)(a.ws + WS_BRANCH), (const f16*)(a.ws + WS_ZS), a.in[9]};
            SUB(2, pg8::gemm_phase<CfgPool, EpiPool, pg8::OneUnit, true, true>(lds, (const char*)(a.ws + WS_PM), (const char*)(a.ws + WS_WPOOL), S1, E); ); }
    );
    PHASE(4,
        SUB(0, for (int it = bx; it < 256; it += G) ssm_scan((LAS float*)lds, it, a.in[10], a.in[11], a.in[12], (const float*)(a.ws + WS_S), (f16*)(a.ws + WS_X)); );
    );
    PHASE(5,
        pg8::ListOrder S; S.init(NG * 4, 2, 2, G, vcu);
        EpiY E{(f16*)(a.ws + WS_YG), (const f16*)(a.ws + WS_X), a.in[17]};
        pg8::gemm_phase<CfgY, EpiY, pg8::ListOrder, true, true>(lds, (const char*)(a.ws + WS_X), (const char*)(a.ws + WS_QG), S, E, (const char*)(a.ws + WS_KTH));
    );
    PHASE(6,
        pg8::DenseOrder S; S.init(M_LAT / 256, SW / 128, G, bx, WGM_GLU);
        EpiGlu E{(f16*)(a.ws + WS_BRANCH), (const f16*)(a.ws + WS_ZS), a.in[19]};
        pg8::gemm_phase<CfgGlu, EpiGlu, pg8::DenseOrder, true, true>(lds, (const char*)(a.ws + WS_YG), (const char*)(a.ws + WS_WGLU), S, E);
    );
    PHASE(7,
        pg8::DenseOrder S; S.init(M_LAT / 256, D / 256, G, bx, WGM_OUT);
        EpiOut E{a.in[0], (f16*)(a.ws + WS_XO), (const float*)(a.ws + WS_MOD), (float*)(a.ws + WS_ROWSS)};
        pg8::gemm_phase<CfgDense2048, EpiOut, pg8::DenseOrder, true, true>(lds, (const char*)(a.ws + WS_BRANCH), (const char*)(a.ws + WS_WOUT), S, E);
    );
    if (PROBE_PH == 8) tp0 = __builtin_amdgcn_s_memrealtime();
    if (IN(8)) final_rows(vcu * NWAVES + wave, lane, (const f16*)(a.ws + WS_XO), a.out, a.in[21], (const float*)(a.ws + WS_ROWSS));
    if (PROBE_PH == 8) { asm volatile("s_waitcnt vmcnt(0)" ::: "memory"); tp1 = __builtin_amdgcn_s_memrealtime(); }
    if (PROBE_PH == 99) { asm volatile("s_waitcnt vmcnt(0)" ::: "memory"); tp1 = __builtin_amdgcn_s_memrealtime(); }
    if (PROBE_PH >= 0 && bx == PROBE_BX && tid == 0) { const unsigned long long t0 = __builtin_amdgcn_s_memrealtime(), span = (tp1 - tp0) * PROBE_MULT; while (__builtin_amdgcn_s_memrealtime() - t0 < span) __builtin_amdgcn_s_sleep(8); }
#undef PHASE
#undef SUB
#undef IN
#undef SEAM
}

#ifndef MK_SPLIT
#define MK_SPLIT 0
#endif
extern "C" void kernel_launch(void* const* d_in, const int* in_sizes, int n_in, void* d_out, int out_size, void* d_ws, size_t ws_size, hipStream_t stream) {
    static int grid = 0;
    if (grid == 0) {
        if (ws_size < WS_END + MiB || n_in != 22) { fprintf(stderr, "kernel_launch: unexpected workspace / inputs: %zu %d\n", ws_size, n_in); grid = -1; return; }
        if (hipFuncSetAttribute((const void*)mk_fwd, hipFuncAttributeMaxDynamicSharedMemorySize, LDS_BYTES) != hipSuccess) { fprintf(stderr, "hipFuncSetAttribute failed\n"); grid = -1; return; }
        int dev = 0, cus = 0, per_cu = 0;
        if (hipGetDevice(&dev) != hipSuccess || hipDeviceGetAttribute(&cus, hipDeviceAttributeMultiprocessorCount, dev) != hipSuccess) { grid = -1; return; }
        if (hipOccupancyMaxActiveBlocksPerMultiprocessor(&per_cu, (const void*)mk_fwd, NTHREADS, LDS_BYTES) != hipSuccess || per_cu < 1) { fprintf(stderr, "occupancy query: %d\n", per_cu); (void)hipGetLastError(); }
        if (cus < 256) { fprintf(stderr, "kernel_launch: built for a 256-CU device (got %d)\n", cus); grid = -1; return; }
        grid = 256;
    }
    if (grid < 0) return;
    if (hipMemsetAsync((char*)d_ws + WS_CTL, 0, CTL_ZERO_BYTES, stream) != hipSuccess) return;
    Args a{}; for (int i = 0; i < 22; ++i) a.in[i] = (const float*)d_in[i]; a.out = (float*)d_out; a.ws = (unsigned char*)d_ws;
#if MK_SPLIT
    for (int ph = 0; ph < 9; ++ph) { a.ph_lo = ph; a.ph_hi = ph + 1; hipLaunchKernelGGL(mk_fwd, dim3(grid), dim3(NTHREADS), LDS_BYTES, stream, a); }
#else
    a.ph_lo = 0; a.ph_hi = 9; hipLaunchKernelGGL(mk_fwd, dim3(grid), dim3(NTHREADS), LDS_BYTES, stream, a);
#endif
}
```
